# Optimizing an MI355X kernel written in HIP

```python
import math
import jax, jax.numpy as jnp
from jax import lax
import numpy as np

D_MODEL = 2048
BATCH = 2
SEQ = 8192
DEPTH = 1

MEM_LEN = 256
LRU_WIDTH = D_MODEL // 2
LRU_BLOCKS = 8
LRU_BLOCK_DIM = LRU_WIDTH // LRU_BLOCKS
LRU_CONV_WIDTH = 4
LRU_C = 8.0
NSA_HEADS = 8
NSA_KV_HEADS = 2
NSA_HEAD_DIM = (D_MODEL // 4) // NSA_HEADS
CMP_STRIDE = 16
CMP_BLOCK = 2 * CMP_STRIDE
SLC_BLOCK = 64
N_SELECT = 16
WINDOW = 512
Q_BLOCK = 128
MEM_HEADS = 4
MEM_HEAD_DIM = (D_MODEL // 4) // MEM_HEADS
D_FF = ((8 * D_MODEL // 3) + 255) // 256 * 256
FFN_CONV_WIDTH = 3

LN_EPS = 1e-5
NEG_INF = -1e30
FORCE_SCORE = 1e9

kernel_name = 'hymba_style_lru_nsa_memxattn_convffn_deepnorm'


def layer_norm(x, g, b):
    xf = x.astype(jnp.float32)
    mu = jnp.mean(xf, axis=-1, keepdims=True)
    var = jnp.mean(jnp.square(xf - mu), axis=-1, keepdims=True)
    y = (xf - mu) * lax.rsqrt(var + LN_EPS)
    return (y * g + b).astype(x.dtype)


def causal_dwconv(x, w, b):
    K = w.shape[0]
    S = x.shape[1]
    xp = jnp.pad(x, ((0, 0), (K - 1, 0), (0, 0)))
    y = b
    for k in range(K):
        y = y + xp[:, k:k + S] * w[k]
    return y


def masked_softmax(s, mask):
    p = jax.nn.softmax(jnp.where(mask, s, NEG_INF), axis=-1)
    return jnp.where(mask, p, 0.0)


def rg_lru_group(xr, yg, conv_w, conv_b, wa, ba, wx, bx, lam):
    B, S, C = xr.shape
    f32 = jnp.float32
    xc = causal_dwconv(xr, conv_w, conv_b).astype(f32)
    xb = xc.reshape(B, S, LRU_BLOCKS, LRU_BLOCK_DIM)
    r = jax.nn.sigmoid(jnp.einsum('bsnc,ncd->bsnd', xb, wa.astype(f32)) + ba).reshape(B, S, C)
    i = jax.nn.sigmoid(jnp.einsum('bsnc,ncd->bsnd', xb, wx.astype(f32)) + bx).reshape(B, S, C)
    log_a = -LRU_C * r * jax.nn.softplus(-lam.astype(f32))
    a = jnp.exp(log_a)
    u = jnp.sqrt(-jnp.expm1(2.0 * log_a)) * (i * xc)

    def combine(left, right):
        a1, b1 = left
        a2, b2 = right
        return a1 * a2, a2 * b1 + b2

    _, h = lax.associative_scan(combine, (a, u), axis=1)
    return (jax.nn.gelu(yg.astype(f32)) * h).astype(xr.dtype)


def compress_blocks(kv, pe, w1, w2):
    B, S, G, Dh = kv.shape
    sub = kv.reshape(B, S // CMP_STRIDE, CMP_STRIDE, G, Dh)
    blocks = jnp.concatenate([sub[:, :-1], sub[:, 1:]], axis=2)
    blocks = blocks + pe[None, None, :, None, :]
    hid = jax.nn.gelu(jnp.einsum('bnlgd,lde->bgne', blocks, w1))
    return jnp.einsum('bgne,ef->bgnf', hid, w2)


def nsa_group(q, kv6, gate_logits, pe_k, w1_k, w2_k, pe_v, w1_v, w2_v):
    B, S, H, Dh = q.shape
    G = NSA_KV_HEADS
    HPG = H // G
    f32 = jnp.float32
    kc_raw, vc_raw, ks, vs, kw, vw = [t.reshape(B, S, G, Dh) for t in kv6]
    k_cmp = compress_blocks(kc_raw, pe_k, w1_k, w2_k)
    v_cmp = compress_blocks(vc_raw, pe_v, w1_v, w2_v)
    n_cmp = k_cmp.shape[2]
    n_slc = S // SLC_BLOCK
    n_top = min(N_SELECT, n_slc)
    k_blk = ks.reshape(B, n_slc, SLC_BLOCK, G, Dh).transpose(0, 3, 1, 2, 4)
    v_blk = vs.reshape(B, n_slc, SLC_BLOCK, G, Dh).transpose(0, 3, 1, 2, 4)
    k_win = jnp.pad(kw, ((0, 0), (WINDOW, 0), (0, 0), (0, 0)))
    v_win = jnp.pad(vw, ((0, 0), (WINDOW, 0), (0, 0), (0, 0)))
    n_q = S // Q_BLOCK
    q_chunks = q.reshape(B, n_q, Q_BLOCK, G, HPG, Dh).transpose(1, 0, 3, 4, 2, 5)
    g_chunks = jax.nn.sigmoid(gate_logits.astype(f32)).reshape(B, n_q, Q_BLOCK, G, HPG, 3).transpose(1, 0, 3, 4, 2, 5)

    cmp_start = jnp.arange(n_cmp) * CMP_STRIDE
    cmp_end = cmp_start + CMP_BLOCK - 1
    blk = jnp.arange(n_slc)
    slc_start = blk * SLC_BLOCK
    cover = ((cmp_start[:, None] <= slc_start[None, :] + SLC_BLOCK - 1)
             & (cmp_end[:, None] >= slc_start[None, :])).astype(f32)
    b_idx = jnp.arange(B)[:, None, None, None]
    g_idx = jnp.arange(G)[None, :, None, None]
    scale = Dh ** -0.5

    def block_fn(args):
        ci, qc, gc = args
        q0 = ci * Q_BLOCK
        t = q0 + jnp.arange(Q_BLOCK)
        s_c = jnp.einsum('bghqd,bgnd->bghqn', qc, k_cmp).astype(f32) * scale
        p_c = masked_softmax(s_c, cmp_end[None, :] <= t[:, None])
        o_c = jnp.einsum('bghqn,bgnd->bghqd', p_c.astype(v_cmp.dtype), v_cmp)
        imp = jnp.einsum('bghqn,ns->bgqs', p_c, cover)
        cur = (t // SLC_BLOCK)[:, None]
        forced = (blk[None, :] == 0) | (blk[None, :] == cur) | (blk[None, :] == cur - 1)
        visible = slc_start[None, :] <= t[:, None]
        imp = jnp.where(forced, FORCE_SCORE, jnp.where(visible, imp, NEG_INF))
        _, idx = lax.top_k(imp, n_top)
        k_sel = k_blk[b_idx, g_idx, idx]
        v_sel = v_blk[b_idx, g_idx, idx]
        s_s = jnp.einsum('bghqd,bgqnkd->bghqnk', qc, k_sel).astype(f32) * scale
        kpos = idx[..., None] * SLC_BLOCK + jnp.arange(SLC_BLOCK)
        m_s = (kpos <= t[None, None, :, None, None]).reshape(B, G, 1, Q_BLOCK, -1)
        p_s = masked_softmax(s_s.reshape(B, G, HPG, Q_BLOCK, -1), m_s)
        o_s = jnp.einsum('bghqm,bgqmd->bghqd', p_s.astype(v_sel.dtype),
                         v_sel.reshape(B, G, Q_BLOCK, -1, Dh))
        k_w = lax.dynamic_slice_in_dim(k_win, q0, Q_BLOCK + WINDOW, axis=1)
        v_w = lax.dynamic_slice_in_dim(v_win, q0, Q_BLOCK + WINDOW, axis=1)
        s_w = jnp.einsum('bghqd,bkgd->bghqk', qc, k_w).astype(f32) * scale
        kp = q0 - WINDOW + jnp.arange(Q_BLOCK + WINDOW)
        m_w = (kp[None, :] <= t[:, None]) & (kp[None, :] > t[:, None] - WINDOW) & (kp[None, :] >= 0)
        p_w = masked_softmax(s_w, m_w)
        o_w = jnp.einsum('bghqk,bkgd->bghqd', p_w.astype(v_w.dtype), v_w)
        gc = gc.astype(f32)
        o = gc[..., 0:1] * o_c + gc[..., 1:2] * o_s + gc[..., 2:3] * o_w
        return o.astype(qc.dtype)

    out = lax.map(block_fn, (jnp.arange(n_q), q_chunks, g_chunks))
    return out.transpose(1, 0, 4, 2, 3, 5).reshape(B, S, H * Dh)


def memory_group(q, mem, w_mem_kv):
    B, S, _ = q.shape
    k, v = jnp.split(mem @ w_mem_kv, 2, axis=-1)
    k = k.reshape(B, -1, MEM_HEADS, MEM_HEAD_DIM)
    v = v.reshape(B, -1, MEM_HEADS, MEM_HEAD_DIM)
    qh = q.reshape(B, S, MEM_HEADS, MEM_HEAD_DIM)
    s = jnp.einsum('bshd,bmhd->bhsm', qh, k).astype(jnp.float32) * (MEM_HEAD_DIM ** -0.5)
    p = jax.nn.softmax(s, axis=-1).astype(v.dtype)
    return jnp.einsum('bhsm,bmhd->bshd', p, v).reshape(B, S, MEM_HEADS * MEM_HEAD_DIM)


def conv_ffn(h, w_up, conv_w, conv_b, w_down):
    up = causal_dwconv(h @ w_up, conv_w, conv_b)
    g, u = jnp.split(up, 2, axis=-1)
    return (jax.nn.gelu(g) * u) @ w_down


def hybrid_layer(h, mem, w_in, lru_conv_w, lru_conv_b, lru_wa, lru_ba, lru_wx, lru_bx, lru_lam,
                 cmp_pe_k, cmp_w1_k, cmp_w2_k, cmp_pe_v, cmp_w1_v, cmp_w2_v, w_mem_kv, w_out,
                 ln1_g, ln1_b, ffn_w_up, ffn_conv_w, ffn_conv_b, ffn_w_down, ln2_g, ln2_b):
    alpha = (2.0 * DEPTH) ** 0.25
    B, S, _ = h.shape
    G, Dh = NSA_KV_HEADS, NSA_HEAD_DIM
    sizes = [LRU_WIDTH, LRU_WIDTH, NSA_HEADS * Dh] + [G * Dh] * 6 + [3 * NSA_HEADS, MEM_HEADS * MEM_HEAD_DIM]
    parts = jnp.split(h @ w_in, np.cumsum(sizes)[:-1].tolist(), axis=-1)
    lru_x, lru_y, nsa_q = parts[0], parts[1], parts[2]
    nsa_kv = parts[3:9]
    nsa_gate, mem_q = parts[9], parts[10]
    o_lru = rg_lru_group(lru_x, lru_y, lru_conv_w, lru_conv_b, lru_wa, lru_ba, lru_wx, lru_bx, lru_lam)
    o_nsa = nsa_group(nsa_q.reshape(B, S, NSA_HEADS, Dh), nsa_kv, nsa_gate.reshape(B, S, NSA_HEADS, 3),
                      cmp_pe_k, cmp_w1_k, cmp_w2_k, cmp_pe_v, cmp_w1_v, cmp_w2_v)
    o_mem = memory_group(mem_q, mem, w_mem_kv)
    mixed = jnp.concatenate([o_lru, o_nsa.astype(o_lru.dtype), o_mem.astype(o_lru.dtype)], axis=-1) @ w_out
    h = layer_norm(alpha * h + mixed, ln1_g, ln1_b)
    h = layer_norm(alpha * h + conv_ffn(h, ffn_w_up, ffn_conv_w, ffn_conv_b, ffn_w_down), ln2_g, ln2_b)
    return h


def setup_inputs(seed: int = 0) -> dict:
    key = jax.random.key(seed)
    ks = jax.random.split(key, 32)
    f32 = jnp.float32
    L = DEPTH
    beta = (8.0 * DEPTH) ** -0.25
    G, Dh = NSA_KV_HEADS, NSA_HEAD_DIM
    n_in = 2 * LRU_WIDTH + NSA_HEADS * Dh + 6 * G * Dh + 3 * NSA_HEADS + MEM_HEADS * MEM_HEAD_DIM
    mix_width = LRU_WIDTH + NSA_HEADS * Dh + MEM_HEADS * MEM_HEAD_DIM

    def nrm(k, shape, scale):
        return jax.random.normal(k, shape, f32) * scale

    u = jax.random.uniform(ks[7], (L, LRU_WIDTH), f32, 0.9, 0.999)
    s = u ** (1.0 / LRU_C)
    lru_lam = jnp.log(s) - jnp.log1p(-s)
    return {
        'x': nrm(ks[0], (BATCH, SEQ, D_MODEL), 1.0),
        'mem': nrm(ks[1], (BATCH, MEM_LEN, D_MODEL), 1.0),
        'ln_in_g': 1.0 + nrm(ks[2], (D_MODEL,), 0.02),
        'ln_in_b': nrm(ks[3], (D_MODEL,), 0.02),
        'w_in': nrm(ks[4], (L, D_MODEL, n_in), D_MODEL ** -0.5),
        'lru_conv_w': nrm(ks[5], (L, LRU_CONV_WIDTH, LRU_WIDTH), LRU_CONV_WIDTH ** -0.5),
        'lru_conv_b': nrm(ks[6], (L, LRU_WIDTH), 0.01),
        'lru_wa': nrm(ks[8], (L, LRU_BLOCKS, LRU_BLOCK_DIM, LRU_BLOCK_DIM), LRU_BLOCK_DIM ** -0.5),
        'lru_ba': nrm(ks[9], (L, LRU_BLOCKS, LRU_BLOCK_DIM), 0.01),
        'lru_wx': nrm(ks[10], (L, LRU_BLOCKS, LRU_BLOCK_DIM, LRU_BLOCK_DIM), LRU_BLOCK_DIM ** -0.5),
        'lru_bx': nrm(ks[11], (L, LRU_BLOCKS, LRU_BLOCK_DIM), 0.01),
        'lru_lam': lru_lam,
        'cmp_pe_k': nrm(ks[12], (L, CMP_BLOCK, Dh), 0.02),
        'cmp_w1_k': nrm(ks[13], (L, CMP_BLOCK, Dh, Dh), (CMP_BLOCK * Dh) ** -0.5),
        'cmp_w2_k': nrm(ks[14], (L, Dh, Dh), Dh ** -0.5),
        'cmp_pe_v': nrm(ks[15], (L, CMP_BLOCK, Dh), 0.02),
        'cmp_w1_v': nrm(ks[16], (L, CMP_BLOCK, Dh, Dh), (CMP_BLOCK * Dh) ** -0.5),
        'cmp_w2_v': nrm(ks[17], (L, Dh, Dh), Dh ** -0.5),
        'w_mem_kv': nrm(ks[18], (L, D_MODEL, 2 * MEM_HEADS * MEM_HEAD_DIM), D_MODEL ** -0.5),
        'w_out': nrm(ks[19], (L, mix_width, D_MODEL), beta * mix_width ** -0.5),
        'ln1_g': 1.0 + nrm(ks[20], (L, D_MODEL), 0.02),
        'ln1_b': nrm(ks[21], (L, D_MODEL), 0.02),
        'ffn_w_up': nrm(ks[22], (L, D_MODEL, 2 * D_FF), D_MODEL ** -0.5),
        'ffn_conv_w': nrm(ks[23], (L, FFN_CONV_WIDTH, 2 * D_FF), FFN_CONV_WIDTH ** -0.5),
        'ffn_conv_b': nrm(ks[24], (L, 2 * D_FF), 0.01),
        'ffn_w_down': nrm(ks[25], (L, D_FF, D_MODEL), beta * D_FF ** -0.5),
        'ln2_g': 1.0 + nrm(ks[26], (L, D_MODEL), 0.02),
        'ln2_b': nrm(ks[27], (L, D_MODEL), 0.02),
    }


def reference(x, mem, ln_in_g, ln_in_b, w_in, lru_conv_w, lru_conv_b, lru_wa, lru_ba, lru_wx, lru_bx,
              lru_lam, cmp_pe_k, cmp_w1_k, cmp_w2_k, cmp_pe_v, cmp_w1_v, cmp_w2_v, w_mem_kv, w_out,
              ln1_g, ln1_b, ffn_w_up, ffn_conv_w, ffn_conv_b, ffn_w_down, ln2_g, ln2_b):
    h = layer_norm(x, ln_in_g, ln_in_b)
    for l in range(DEPTH):
        h = hybrid_layer(h, mem, w_in[l], lru_conv_w[l], lru_conv_b[l], lru_wa[l], lru_ba[l],
                         lru_wx[l], lru_bx[l], lru_lam[l], cmp_pe_k[l], cmp_w1_k[l], cmp_w2_k[l],
                         cmp_pe_v[l], cmp_w1_v[l], cmp_w2_v[l], w_mem_kv[l], w_out[l],
                         ln1_g[l], ln1_b[l], ffn_w_up[l], ffn_conv_w[l], ffn_conv_b[l],
                         ffn_w_down[l], ln2_g[l], ln2_b[l])
    return h
```

```cpp
#include <hip/hip_runtime.h>
#include <hip/hip_cooperative_groups.h>
#include <cstdio>
namespace cg = cooperative_groups;
namespace pg8 {
#define PG8_LAS __attribute__((address_space(3)))
typedef unsigned short bf16_t;
typedef short bf16x8 __attribute__((ext_vector_type(8)));
typedef float f32x4 __attribute__((ext_vector_type(4)));
typedef unsigned u32x4 __attribute__((ext_vector_type(4)));
constexpr int BM = 256, BK = 64, HALF = 128, HTB = HALF * BK * 2  , STAGE_BYTES = 8 * HTB, NXCD = 8, WGM = 8;

__host__ __device__ __forceinline__ int lds_byte(int r, int c) { const int st = (r >> 4) * 2 + (c >> 5), rr = r & 15, cc = c & 31, ob = rr * 64 + cc * 2; return st * 1024 + (ob ^ (((ob >> 9) & 1) << 5)); }
__host__ __device__ __forceinline__ void stage_rc(int b, int& R, int& C) { const int st = b / 1024, sb = b % 1024, swz = sb ^ (((sb >> 9) & 1) << 5); R = (st >> 1) * 16 + swz / 64; C = (st & 1) * 32 + (swz % 64) / 2; }
__host__ __device__ __forceinline__ int perm32(int rho) { const int n = rho >> 4, i = rho & 15; return 8 * (i >> 2) + 4 * n + (i & 3); }

struct Unit { int pm, pn; };
struct Gemm { const bf16_t* A; const bf16_t* Bt; int M, N, K; int halo; };
__device__ __forceinline__ long long a_off(const Gemm& g, int pm) { return g.halo ? ((long long)((pm / 33) * 8192 + (pm % 33) * 254 - 2) * g.K * 2) : ((long long)pm * 256 * g.K * 2); }

struct StaticOrder {
    int nM, nN, nwg, G, c;
    __host__ __device__ void init(int M, int N, int G_, int c_) { nM = M / BM; nN = N / BM; nwg = nM * nN; G = G_; c = c_; }
    __host__ __device__ bool next(int i, Unit& u) const {
        const long L = (long)i * G + c; if (L >= nwg) return false;
        int wgid = (int)L; { const int q = nwg / NXCD, r = nwg % NXCD, xcd = wgid % NXCD, off = wgid / NXCD; wgid = (xcd < r ? xcd * (q + 1) : r * (q + 1) + (xcd - r) * q) + off; }
        const int nig = WGM * nN, gid = wgid / nig, fm = gid * WGM, gsz = (nM - fm) < WGM ? (nM - fm) : WGM;
        u.pm = fm + ((wgid % nig) % gsz); u.pn = (wgid % nig) / gsz; return true;
    }
    __device__ __forceinline__ void a_ready(const Unit&) const {}
    __device__ __forceinline__ void done(const Unit&) const {}
};
__device__ __forceinline__ unsigned cvt_pk_bf16(float lo, float hi) { unsigned r; asm volatile("v_cvt_pk_bf16_f32 %0, %1, %2" : "=v"(r) : "v"(lo), "v"(hi)); return r; }
typedef float f32x2 __attribute__((ext_vector_type(2)));
__device__ __forceinline__ f32x2 gelu_pk(f32x2 v) {
    const f32x2 av = __builtin_elementwise_abs(v), d = av * 0.2316418882f + 1.0f;
    f32x2 t; t.x = __builtin_amdgcn_rcpf(d.x); t.y = __builtin_amdgcn_rcpf(d.y);
    f32x2 q = t * 0.5307027145f + (-0.7265760135f); q = q * t + 0.7107068705f; q = q * t + (-0.142248368f); q = q * t + 0.127414796f; q = q * t;
    const f32x2 s = (v * v) * (-0.72134752044f);
    f32x2 e; e.x = __builtin_amdgcn_exp2f(s.x); e.y = __builtin_amdgcn_exp2f(s.y);
    const f32x2 m = v * (q * e), r = v - m;
    f32x2 o; o.x = v.x < 0.f ? m.x : r.x; o.y = v.y < 0.f ? m.y : r.y; return o;
}

template <int ACT  > struct EpiBf16 {
    static constexpr bool PERM = true, AFTER_DRAIN = false;
    bf16_t* O; int ldc; const float* bias; int split_cols; size_t split_stride;
    __device__ __forceinline__ void operator()(const f32x4 (&acc)[2][2][4][2], const Unit& u, int wr, int wc, int fr, int fq) const {
        const int row0 = u.pm * BM + wr * 64 + fr; int colt = u.pn * BM; bf16_t* base = O;
        if (split_cols) { const int t = colt / split_cols; base += (size_t)t * split_stride; colt -= t * split_cols; }
        const int col0 = colt + wc * 32 + 8 * fq, bcol0 = u.pn * BM + wc * 32 + 8 * fq;
        f32x4 bv[2][2];
#pragma unroll
        for (int bj = 0; bj < 2; ++bj)
#pragma unroll
            for (int n = 0; n < 2; ++n) bv[bj][n] = bias ? *(const f32x4*)(bias + bcol0 + bj * HALF + 4 * n) : (f32x4){0.f, 0.f, 0.f, 0.f};
#pragma unroll
        for (int ai = 0; ai < 2; ++ai)
#pragma unroll
            for (int m = 0; m < 4; ++m) { bf16_t* rowp = base + (size_t)(row0 + ai * HALF + m * 16) * ldc + col0;
#pragma unroll
                for (int bj = 0; bj < 2; ++bj) { f32x4 v0 = acc[ai][bj][m][0] + bv[bj][0], v1 = acc[ai][bj][m][1] + bv[bj][1];
                    if (ACT == 1) { f32x2 a = gelu_pk((f32x2){v0[0], v0[1]}), b = gelu_pk((f32x2){v0[2], v0[3]}), c = gelu_pk((f32x2){v1[0], v1[1]}), d = gelu_pk((f32x2){v1[2], v1[3]});
                        v0 = (f32x4){a.x, a.y, b.x, b.y}; v1 = (f32x4){c.x, c.y, d.x, d.y}; }
                    if (ACT == 2) {
#pragma unroll
                        for (int j = 0; j < 4; ++j) { v0[j] = 0.5f * v0[j] * (1.0f + erff(v0[j] * 0.70710678f)); v1[j] = 0.5f * v1[j] * (1.0f + erff(v1[j] * 0.70710678f)); } }
                    u32x4 w; w.x = cvt_pk_bf16(v0[0], v0[1]); w.y = cvt_pk_bf16(v0[2], v0[3]); w.z = cvt_pk_bf16(v1[0], v1[1]); w.w = cvt_pk_bf16(v1[2], v1[3]);
                    *(u32x4*)(rowp + bj * HALF) = w; } }
    }
};
struct EpiResF32 {
    static constexpr bool PERM = false, AFTER_DRAIN = false;
    float* C; const float* base; int ldc; float alpha;
    __device__ __forceinline__ void operator()(const f32x4 (&acc)[2][2][4][2], const Unit& u, int wr, int wc, int fr, int fq) const {
        const int row0 = u.pm * BM + wr * 64 + fr, col0 = u.pn * BM + wc * 32 + 4 * fq;
#pragma unroll
        for (int ai = 0; ai < 2; ++ai)
#pragma unroll
            for (int m = 0; m < 4; ++m) { const size_t off = (size_t)(row0 + ai * HALF + m * 16) * ldc + col0;
#pragma unroll
                for (int bj = 0; bj < 2; ++bj)
#pragma unroll
                    for (int n = 0; n < 2; ++n) { const f32x4 bs = *(const f32x4*)(base + off + bj * HALF + n * 16); *(f32x4*)(C + off + bj * HALF + n * 16) = bs * alpha + acc[ai][bj][m][n]; } }
    }
};
template <int CTRL> __device__ __forceinline__ float dppf(float old, float src) {
    return __builtin_bit_cast(float, __builtin_amdgcn_update_dpp(__builtin_bit_cast(int, old), __builtin_bit_cast(int, src), CTRL, 0xf, 0xf, false));
}
__device__ __forceinline__ float gelu_tanh(float x) {
    const float u = 1.5957691216f * (x + 0.044715f * x * x * x);
    return x * __builtin_amdgcn_rcpf(1.0f + __expf(-u));
}
struct EpiConvGeglu {
    static constexpr bool PERM = true, AFTER_DRAIN = false;
    bf16_t* ACT; const float* cw; const float* cb; PG8_LAS float* EX;
    __device__ __forceinline__ void operator()(const f32x4 (&acc)[2][2][4][2], const Unit& u, int wr, int wc, int fr, int fq) const {
        const int b = u.pm / 33, j = u.pm % 33, colu = wc * 32 + 8 * fq;
        if (fr >= 14) {
#pragma unroll
            for (int ai = 0; ai < 2; ++ai)
#pragma unroll
                for (int bj = 0; bj < 2; ++bj)
#pragma unroll
                    for (int n = 0; n < 2; ++n) *(PG8_LAS f32x4*)(EX + ((ai * 2 + wr) * 2 + (fr - 14)) * 256 + bj * 128 + colu + 4 * n) = acc[ai][bj][3][n];
        }
        asm volatile("s_waitcnt lgkmcnt(0)" ::: "memory"); __builtin_amdgcn_s_barrier(); __builtin_amdgcn_s_barrier(); asm volatile("" ::: "memory");
        const int tb = j * 254 - 2; const bool zr = (j == 0) && (wr == 0) && (fr < 2);
        const f32x4 z4 = (f32x4){0.f, 0.f, 0.f, 0.f};
#pragma unroll
        for (int n = 0; n < 2; ++n) {
            const int ca = u.pn * 128 + colu + 4 * n;
            f32x4 wg[3], wu[3];
#pragma unroll
            for (int k = 0; k < 3; ++k) { wg[k] = *(const f32x4*)(cw + k * 11264 + ca); wu[k] = *(const f32x4*)(cw + k * 11264 + 5632 + ca); }
            const f32x4 bg = *(const f32x4*)(cb + ca), bu = *(const f32x4*)(cb + 5632 + ca);
#pragma unroll
            for (int ai = 0; ai < 2; ++ai) {
                f32x4 pg = z4, pu = z4;
                if (!(ai == 0 && wr == 0)) { const int slot = (wr == 1) ? (ai * 2) : ((ai - 1) * 2 + 1);
                    pg = *(const PG8_LAS f32x4*)(EX + (slot * 2 + (fr & 1)) * 256 + colu + 4 * n); pu = *(const PG8_LAS f32x4*)(EX + (slot * 2 + (fr & 1)) * 256 + 128 + colu + 4 * n); }
#pragma unroll
                for (int m = 0; m < 4; ++m) {
                    f32x4 xg = acc[ai][0][m][n], xu = acc[ai][1][m][n];
                    if (ai == 0 && m == 0 && zr) { xg = z4; xu = z4; }
                    float a4[4];
#pragma unroll
                    for (int e = 0; e < 4; ++e) {
                        const float g1 = dppf<0x111>(dppf<0x121>(0.f, pg[e]), xg[e]), g2 = dppf<0x112>(dppf<0x122>(0.f, pg[e]), xg[e]);
                        const float u1 = dppf<0x111>(dppf<0x121>(0.f, pu[e]), xu[e]), u2 = dppf<0x112>(dppf<0x122>(0.f, pu[e]), xu[e]);
                        const float cg = bg[e] + wg[0][e] * g2 + wg[1][e] * g1 + wg[2][e] * xg[e];
                        const float cu = bu[e] + wu[0][e] * u2 + wu[1][e] * u1 + wu[2][e] * xu[e];
                        a4[e] = gelu_tanh(cg) * cu;
                    }
                    pg = xg; pu = xu;
                    const int tr = ai * 128 + wr * 64 + m * 16 + fr, t = tb + tr;
                    if (tr >= 2 && t < 8192) { unsigned long long w = (unsigned long long)cvt_pk_bf16(a4[0], a4[1]) | ((unsigned long long)cvt_pk_bf16(a4[2], a4[3]) << 32);
                        *(unsigned long long*)(ACT + (size_t)(b * 8192 + t) * 5632 + ca) = w; }
                }
            }
        }
    }
};
template <class Epi, class Sched, bool STAMP = false>
__device__ __forceinline__ void gemm_phase(PG8_LAS unsigned char* lds, const Gemm g, const Sched& S, const Epi& E, unsigned long long* stamps) {
    const int tid = threadIdx.x, wid = __builtin_amdgcn_readfirstlane(tid >> 6), lane = tid & 63, wr = wid >> 2, wc = wid & 3, fr = lane & 15, fq = lane >> 4;
    const int K = g.K, nt = K / BK;
    int ts_lo = 0, ts_hi = 0, nts = 0; const unsigned long long rt_entry = STAMP ? (unsigned long long)wall_clock64() : 0ull;
#define PG8_STAMP() do { if (STAMP && wid == 0 && nts < 64) { const unsigned long long _c = (unsigned long long)clock64(); \
        ts_lo = (lane == nts) ? (int)(unsigned)_c : ts_lo; ts_hi = (lane == nts) ? (int)(unsigned)(_c >> 32) : ts_hi; ++nts; } } while (0)
    PG8_STAMP();
    unsigned voffA[2], voffB[2];
#pragma unroll
    for (int i = 0; i < 2; ++i) { int R, C; stage_rc(tid * 16 + i * 8192, R, C); const int Rb = Epi::PERM ? ((R & ~31) + perm32(R & 31)) : R;
        voffA[i] = (unsigned)(R * K + C) * 2u; voffB[i] = (unsigned)(Rb * K + C) * 2u; }
    const size_t kstep = (size_t)(BK * 2);
    const size_t hstep = (size_t)HALF * K * 2;
    const size_t tstep = 2 * hstep;
    const unsigned ldsw = (unsigned)wid * 1024u;
    const int aoff = lds_byte(wr * 64 + fr, fq * 8), boff = lds_byte(wc * 32 + fr, fq * 8);
#define PG8_SA(b, h) (((b) * 2 + (h)) * HTB)
#define PG8_SB(b, h) ((4 + (b) * 2 + (h)) * HTB)
#define PG8_STAGE(bufoff, gbase, voff) do { _Pragma("unroll") for (int _i = 0; _i < 2; ++_i) \
        __builtin_amdgcn_global_load_lds((const unsigned*)((const char*)(gbase) + (voff)[_i]), (PG8_LAS unsigned*)(lds + (bufoff) + ldsw + _i * 8192), 16, 0, 0); } while (0)
#define PG8_LDA(dst, b, h) do { _Pragma("unroll") for (int m = 0; m < 4; ++m) _Pragma("unroll") for (int k = 0; k < 2; ++k) dst[m][k] = *(const PG8_LAS bf16x8*)(lds + PG8_SA(b, h) + aoff + m * 2048 + k * 1024); } while (0)
#define PG8_LDB(dst, b, h) do { _Pragma("unroll") for (int n = 0; n < 2; ++n) _Pragma("unroll") for (int k = 0; k < 2; ++k) dst[n][k] = *(const PG8_LAS bf16x8*)(lds + PG8_SB(b, h) + boff + n * 2048 + k * 1024); } while (0)
#define PG8_MMA(ai, bj, At, Bt) do { __builtin_amdgcn_s_setprio(1); _Pragma("unroll") for (int m = 0; m < 4; ++m) _Pragma("unroll") for (int n = 0; n < 2; ++n) _Pragma("unroll") for (int k = 0; k < 2; ++k) \
        acc[ai][bj][m][n] = __builtin_amdgcn_mfma_f32_16x16x32_bf16(Bt[n][k], At[m][k], acc[ai][bj][m][n], 0, 0, 0); __builtin_amdgcn_s_setprio(0); } while (0)
#define PG8_WAIT_V(n) asm volatile("s_waitcnt vmcnt(" #n ")" ::: "memory")
#define PG8_WAIT_L(n) asm volatile("s_waitcnt lgkmcnt(" #n ")" ::: "memory")
#define PG8_BAR __builtin_amdgcn_s_barrier()
#define PG8_SCHED __builtin_amdgcn_sched_barrier(0)
    Unit cur, nxt; int ui = 0;
    if (!S.next(0, cur)) return;
    f32x4 acc[2][2][4][2];
#pragma unroll
    for (int a = 0; a < 2; ++a)
#pragma unroll
        for (int b = 0; b < 2; ++b)
#pragma unroll
            for (int m = 0; m < 4; ++m)
#pragma unroll
                for (int n = 0; n < 2; ++n) acc[a][b][m][n] = (f32x4){0.f, 0.f, 0.f, 0.f};
    bf16x8 At[4][2], B0[2][2], B1[2][2];
    const char* cA = (const char*)g.A + a_off(g, cur.pm); const char* cB = (const char*)g.Bt + (size_t)cur.pn * tstep;
    S.a_ready(cur);
    PG8_STAGE(PG8_SB(0, 0), cB, voffB); PG8_STAGE(PG8_SA(0, 0), cA, voffA); PG8_STAGE(PG8_SB(0, 1), cB + hstep, voffB); PG8_STAGE(PG8_SA(0, 1), cA + hstep, voffA);
    if (wr == 1) PG8_BAR;
    PG8_WAIT_V(4); PG8_BAR;
    PG8_STAGE(PG8_SB(1, 0), cB + kstep, voffB); PG8_STAGE(PG8_SA(1, 0), cA + kstep, voffA); PG8_STAGE(PG8_SB(1, 1), cB + hstep + kstep, voffB);
    PG8_WAIT_V(6); PG8_BAR;
    PG8_STAMP();
    for (;;) {
        const bool has_next = S.next(ui + 1, nxt);
        const char* nA = has_next ? (const char*)g.A + a_off(g, nxt.pm) : cA; const char* nB = has_next ? (const char*)g.Bt + (size_t)nxt.pn * tstep : cB;
        for (int t = 0; t < nt; t += 2) {
            const bool last = (t == nt - 2);
            const char* a1 = cA + (size_t)(t + 1) * kstep;
            const char* a2 = last ? nA : cA + (size_t)(t + 2) * kstep; const char* b2 = last ? nB : cB + (size_t)(t + 2) * kstep;
            const char* a3 = a2 + kstep; const char* b3 = b2 + kstep;
            if (last && has_next) S.a_ready(nxt);
            PG8_LDB(B0, 0, 0); PG8_SCHED; PG8_LDA(At, 0, 0); PG8_STAGE(PG8_SA(1, 1), a1 + hstep, voffA);
            PG8_WAIT_L(8); PG8_BAR; PG8_WAIT_L(0); PG8_MMA(0, 0, At, B0); PG8_BAR; PG8_SCHED;
            PG8_LDB(B1, 0, 1); PG8_STAGE(PG8_SB(0, 0), b2, voffB);
            PG8_BAR; PG8_WAIT_L(0); PG8_MMA(0, 1, At, B1); PG8_BAR;
            PG8_LDA(At, 0, 1); PG8_STAGE(PG8_SA(0, 0), a2, voffA);
            PG8_BAR; PG8_WAIT_L(0); PG8_MMA(1, 0, At, B0); PG8_BAR; PG8_SCHED;
            PG8_STAGE(PG8_SB(0, 1), b2 + hstep, voffB);
            PG8_WAIT_V(6); PG8_BAR; PG8_MMA(1, 1, At, B1); PG8_BAR;
            PG8_LDB(B0, 1, 0); PG8_SCHED; PG8_LDA(At, 1, 0); PG8_STAGE(PG8_SA(0, 1), a2 + hstep, voffA);
            PG8_WAIT_L(8); PG8_BAR; PG8_WAIT_L(0); PG8_MMA(0, 0, At, B0); PG8_BAR; PG8_SCHED;
            PG8_LDB(B1, 1, 1); PG8_STAGE(PG8_SB(1, 0), b3, voffB);
            PG8_BAR; PG8_WAIT_L(0); PG8_MMA(0, 1, At, B1); PG8_BAR;
            PG8_LDA(At, 1, 1); PG8_STAGE(PG8_SA(1, 0), a3, voffA);
            PG8_BAR; PG8_WAIT_L(0); PG8_MMA(1, 0, At, B0); PG8_BAR; PG8_SCHED;
            PG8_STAGE(PG8_SB(1, 1), b3 + hstep, voffB);
            PG8_WAIT_V(6); PG8_BAR; PG8_MMA(1, 1, At, B1); PG8_BAR;
        }
        PG8_STAMP();
        if constexpr (!Epi::AFTER_DRAIN) { E(acc, cur, wr, wc, fr, fq); S.done(cur); }
        PG8_STAMP();
        if (!has_next) break;
#pragma unroll
        for (int a = 0; a < 2; ++a)
#pragma unroll
            for (int b = 0; b < 2; ++b)
#pragma unroll
                for (int m = 0; m < 4; ++m)
#pragma unroll
                    for (int n = 0; n < 2; ++n) acc[a][b][m][n] = (f32x4){0.f, 0.f, 0.f, 0.f};
        cur = nxt; cA = nA; cB = nB; ++ui;
    }
    PG8_WAIT_V(0);
    if (wr == 0) PG8_BAR;
    PG8_BAR;
    if constexpr (Epi::AFTER_DRAIN) { E.fused(acc, cur, wr, wc, fr, fq, lds, wid, lane); S.done(cur); }
    PG8_STAMP();
    if (STAMP && wid == 0) { stamps[lane] = lane < nts ? (((unsigned long long)(unsigned)ts_hi << 32) | (unsigned)ts_lo) : 0ull;
        if (lane == 62) stamps[62] = rt_entry; if (lane == 63) stamps[63] = (unsigned long long)wall_clock64(); }
#undef PG8_STAMP
#undef PG8_SA
#undef PG8_SB
#undef PG8_STAGE
#undef PG8_LDA
#undef PG8_LDB
#undef PG8_MMA
#undef PG8_WAIT_V
#undef PG8_WAIT_L
#undef PG8_BAR
#undef PG8_SCHED
}
}
#define LAS __attribute__((address_space(3)))
typedef unsigned short bf16_t;
using pg8::bf16x8; using pg8::f32x4; using pg8::u32x4;
typedef unsigned u32x2 __attribute__((ext_vector_type(2)));
#define MFMA16(a, b, c) __builtin_amdgcn_mfma_f32_16x16x32_bf16(a, b, c, 0, 0, 0)
#define LDS_WAIT() asm volatile("s_waitcnt lgkmcnt(0)" ::: "memory")

constexpr int T = 16384, S = 8192, D = 2048, NINP = 4096, NIN = 3864, DFF = 5632;
constexpr int C_LRUY = 1024, C_Q = 2048, C_KC = 2560, C_VC = 2688, C_KS = 2816, C_VS = 2944, C_KW = 3072, C_VW = 3200, C_GATE = 3328, C_MQ = 3352;
constexpr size_t MiB = (size_t)1 << 20, KiB = 1024;
constexpr size_t WS_WIN = 2 * MiB, WS_WOUT = 18 * MiB, WS_WUP = 26 * MiB, WS_WDOWN = 70 * MiB, WS_WMEM = 92 * MiB, WS_MEMB = 96 * MiB;
constexpr size_t WS_WAT = 98 * MiB, WS_WXT = WS_WAT + 256 * KiB, WS_W1K = WS_WAT + 512 * KiB, WS_W1V = WS_WAT + 768 * KiB, WS_W2K = WS_WAT + 1024 * KiB, WS_W2V = WS_WAT + 1032 * KiB;
constexpr size_t WS_MK = 100 * MiB, WS_MVT = WS_MK + 512 * KiB, WS_KCMP = 101 * MiB, WS_VCMPT = WS_KCMP + 256 * KiB, WS_AGG = 102 * MiB;
constexpr size_t WS_VST = 104 * MiB, WS_VWT = 108 * MiB, WS_H0F = 112 * MiB, WS_H0B = 240 * MiB, WS_P = 304 * MiB, WS_CAT = 432 * MiB, WS_END = 496 * MiB;
constexpr size_t WS_H1B = WS_H0B, WS_ACT = WS_P;
constexpr int LDS_BYTES = 147456, EX_OFF = 131072;
constexpr float ALPHA = 1.189207115002721f, LN_EPS = 1e-5f;

struct Args { const float* in[28]; float* out; unsigned char* ws; int ph_lo, ph_hi; };
struct Ctx {
    const float *x, *mem, *ln_in_g, *ln_in_b, *w_in, *lru_cw, *lru_cb, *lru_wa, *lru_ba, *lru_wx, *lru_bx, *lru_lam, *pe_k, *w1k, *w2k, *pe_v, *w1v, *w2v, *w_mem, *w_out, *ln1_g, *ln1_b, *w_up, *fcw, *fcb, *w_down, *ln2_g, *ln2_b;
    float* out; float* H0F; float2* AGG;
    bf16_t *WinT, *WoutT, *WupT, *WdownT, *WmemT, *MEMB, *WaT, *WxT, *W1kT, *W1vT, *W2kT, *W2vT, *MK, *MVT, *KCMP, *VCMPT, *VsT, *VwT, *H0B, *P, *CAT, *H1B, *ACT;
};

__device__ __forceinline__ float bf2f(unsigned short b) { return __uint_as_float((unsigned)b << 16); }
__device__ __forceinline__ unsigned pkbf(float lo, float hi) { return pg8::cvt_pk_bf16(lo, hi); }
__device__ __forceinline__ bf16_t f2bf1(float v) { return (bf16_t)(pkbf(v, 0.f) & 0xffffu); }
__device__ __forceinline__ bf16x8 ld8(const bf16_t* p) { return __builtin_bit_cast(bf16x8, *(const u32x4*)p); }
__device__ __forceinline__ bf16x8 pack8(const f32x4 a, const f32x4 b) { u32x4 w; w.x = pkbf(a[0], a[1]); w.y = pkbf(a[2], a[3]); w.z = pkbf(b[0], b[1]); w.w = pkbf(b[2], b[3]); return __builtin_bit_cast(bf16x8, w); }
__device__ __forceinline__ bf16x8 join8(const u32x2 a, const u32x2 b) { u32x4 w; w.x = a.x; w.y = a.y; w.z = b.x; w.w = b.y; return __builtin_bit_cast(bf16x8, w); }
__device__ __forceinline__ bf16x8 scale8(const bf16x8 v, float s) { const u32x4 w = __builtin_bit_cast(u32x4, v); u32x4 o;
    o.x = pkbf(__uint_as_float(w.x << 16) * s, __uint_as_float(w.x & 0xffff0000u) * s); o.y = pkbf(__uint_as_float(w.y << 16) * s, __uint_as_float(w.y & 0xffff0000u) * s);
    o.z = pkbf(__uint_as_float(w.z << 16) * s, __uint_as_float(w.z & 0xffff0000u) * s); o.w = pkbf(__uint_as_float(w.w << 16) * s, __uint_as_float(w.w & 0xffff0000u) * s); return __builtin_bit_cast(bf16x8, o); }
__device__ __forceinline__ float wave_sum(float v) {
#pragma unroll
    for (int o = 1; o < 64; o <<= 1) v += __shfl_xor(v, o);
    return v; }
__device__ __forceinline__ float sigmoidf_(float x) { return __builtin_amdgcn_rcpf(1.0f + __expf(-x)); }
__device__ __forceinline__ float rdlane(float v, int l) { return __builtin_bit_cast(float, __builtin_amdgcn_readlane(__builtin_bit_cast(int, v), l)); }
using pg8::gelu_tanh;

template <int MODE>
__device__ __forceinline__ void transpose_item(const float* W, int K, int N, bf16_t* WT, LAS float* scr, int item, int nblk, int lane) {
    const int kb = item / nblk, nb = item % nblk, k0 = 64 * kb, n0 = 32 * nb, nn = n0 + (lane & 31);
#pragma unroll 8
    for (int i = 0; i < 32; ++i) { const int kk = 2 * i + (lane >> 5); scr[kk * 33 + (lane & 31)] = (nn < N) ? W[(size_t)(k0 + kk) * N + nn] : 0.f; }
    LDS_WAIT();
    const int c = lane & 7;
#pragma unroll
    for (int j = 0; j < 4; ++j) { const int n = (lane >> 3) + 8 * j; const LAS float* s = scr + (8 * c) * 33 + n;
        u32x4 o; o.x = pkbf(s[0], s[33]); o.y = pkbf(s[66], s[99]); o.z = pkbf(s[132], s[165]); o.w = pkbf(s[198], s[231]);
        int row = n0 + n;
        if (MODE == 1) { const int bj = row / 5632, rem = row % 5632; row = 256 * (rem / 128) + 128 * bj + (rem % 128); }
        *(u32x4*)(WT + (size_t)row * K + k0 + 8 * c) = o; }
    LDS_WAIT();
}
__device__ __forceinline__ void ln_row(const float* xr, const float* g, const float* bt, float* of, bf16_t* ob, int lane) {
    f32x4 v[8]; float s = 0.f;
#pragma unroll
    for (int j = 0; j < 8; ++j) { v[j] = ((const f32x4*)xr)[lane + 64 * j]; s += (v[j][0] + v[j][1]) + (v[j][2] + v[j][3]); }
    const float mean = wave_sum(s) * (1.f / 2048.f); float s2 = 0.f;
#pragma unroll
    for (int j = 0; j < 8; ++j) { v[j] = v[j] - mean; s2 += (v[j][0] * v[j][0] + v[j][1] * v[j][1]) + (v[j][2] * v[j][2] + v[j][3] * v[j][3]); }
    const float rstd = 1.0f / sqrtf(wave_sum(s2) * (1.f / 2048.f) + LN_EPS);
#pragma unroll
    for (int j = 0; j < 8; ++j) { const f32x4 gg = ((const f32x4*)g)[lane + 64 * j], bb = ((const f32x4*)bt)[lane + 64 * j]; const f32x4 y = v[j] * rstd * gg + bb;
        if (of) ((f32x4*)of)[lane + 64 * j] = y;
        if (ob) { u32x2 w; w.x = pkbf(y[0], y[1]); w.y = pkbf(y[2], y[3]); ((u32x2*)ob)[lane + 64 * j] = w; } }
}
__device__ __forceinline__ void phase0(const Ctx& c, LAS unsigned char* lds, int gw, int NGW, int wave, int lane) {
    LAS float* scr = (LAS float*)(lds + wave * 16384);
    constexpr int I0 = 32 * 128, I1 = 32 * 64, I2 = 32 * 352, I3 = 88 * 64, I4 = 32 * 32, I5 = 64, I6 = 64, I7 = 64, I8 = 64, I9 = 2, I10 = 2;
    constexpr int NIT = I0 + I1 + I2 + I3 + I4 + I5 + I6 + I7 + I8 + I9 + I10;
    for (int it = gw; it < NIT; it += NGW) {
        int r = it;
        if (r < I0) { transpose_item<0>(c.w_in, 2048, NIN, c.WinT, scr, r, 128, lane); continue; } r -= I0;
        if (r < I1) { transpose_item<0>(c.w_out, 2048, 2048, c.WoutT, scr, r, 64, lane); continue; } r -= I1;
        if (r < I2) { transpose_item<1>(c.w_up, 2048, 11264, c.WupT, scr, r, 352, lane); continue; } r -= I2;
        if (r < I3) { transpose_item<0>(c.w_down, 5632, 2048, c.WdownT, scr, r, 64, lane); continue; } r -= I3;
        if (r < I4) { transpose_item<0>(c.w_mem, 2048, 1024, c.WmemT, scr, r, 32, lane); continue; } r -= I4;
        if (r < I5) { transpose_item<0>(c.lru_wa + (r >> 3) * 16384, 128, 128, c.WaT + (r >> 3) * 16384, scr, r & 7, 4, lane); continue; } r -= I5;
        if (r < I6) { transpose_item<0>(c.lru_wx + (r >> 3) * 16384, 128, 128, c.WxT + (r >> 3) * 16384, scr, r & 7, 4, lane); continue; } r -= I6;
        if (r < I7) { transpose_item<0>(c.w1k, 2048, 64, c.W1kT, scr, r, 2, lane); continue; } r -= I7;
        if (r < I8) { transpose_item<0>(c.w1v, 2048, 64, c.W1vT, scr, r, 2, lane); continue; } r -= I8;
        if (r < I9) { transpose_item<0>(c.w2k, 64, 64, c.W2kT, scr, r, 2, lane); continue; } r -= I9;
        transpose_item<0>(c.w2v, 64, 64, c.W2vT, scr, r, 2, lane);
    }
    for (int m = gw; m < T; m += NGW) ln_row(c.x + (size_t)m * D, c.ln_in_g, c.ln_in_b, c.H0F + (size_t)m * D, c.H0B + (size_t)m * D, lane);
    for (int i = gw * 64 + lane; i < 512 * 2048 / 4; i += NGW * 64) { const f32x4 v = ((const f32x4*)c.mem)[i]; u32x2 w; w.x = pkbf(v[0], v[1]); w.y = pkbf(v[2], v[3]); ((u32x2*)c.MEMB)[i] = w; }
}
template <bool PASS2>
__device__ __forceinline__ void lru_tile(const Ctx& c, LAS unsigned char* lds, int tile, int tid) {
    const int n = tile & 7, ck = (tile >> 3) & 127, b = tile >> 10, lane = tid & 63, w = tid >> 6;
    LAS float* XC = (LAS float*)lds; LAS bf16_t* XB = (LAS bf16_t*)(lds + 32768); LAS float* AA = (LAS float*)(lds + 51200); LAS float* UU = (LAS float*)(lds + 83968);
    LAS float* SEG = (LAS float*)(lds + 116736); LAS float* SEG2 = (LAS float*)(lds + 120832);
    const size_t row0 = (size_t)b * S + ck * 64;
    { const int ch = tid & 127, tq = tid >> 7, chg = n * 128 + ch;
      const float w0 = c.lru_cw[chg], w1 = c.lru_cw[1024 + chg], w2 = c.lru_cw[2048 + chg], w3 = c.lru_cw[3072 + chg], cb = c.lru_cb[chg];
      const int tl0 = tq * 16, tt0 = ck * 64 + tl0; const bf16_t* xp = c.P + (size_t)b * S * NINP + chg;
#define LDX(tt) ((tt) >= 0 ? bf2f(xp[(size_t)(tt) * NINP]) : 0.f)
      float x0 = LDX(tt0 - 3), x1 = LDX(tt0 - 2), x2 = LDX(tt0 - 1);
#pragma unroll 4
      for (int i = 0; i < 16; ++i) { const float x3 = LDX(tt0 + i); const float xc = cb + w0 * x0 + w1 * x1 + w2 * x2 + w3 * x3; XC[(tl0 + i) * 128 + ch] = xc; XB[(tl0 + i) * 136 + ch] = f2bf1(xc); x0 = x1; x1 = x2; x2 = x3; }
#undef LDX
    }
    __syncthreads();
    { const int r = lane & 15, q = lane >> 4; f32x4 ga[4], gx[4];
#pragma unroll
      for (int i = 0; i < 4; ++i) { ga[i] = (f32x4){0.f, 0.f, 0.f, 0.f}; gx[i] = ga[i]; }
#pragma unroll
      for (int ks = 0; ks < 4; ++ks) { const size_t wo = ((size_t)n * 128 + 16 * w + r) * 128 + 32 * ks + 8 * q; const bf16x8 ba = ld8(c.WaT + wo), bx = ld8(c.WxT + wo);
#pragma unroll
          for (int rt = 0; rt < 4; ++rt) { const bf16x8 a = *(const LAS bf16x8*)(XB + (16 * rt + r) * 136 + 32 * ks + 8 * q); ga[rt] = MFMA16(a, ba, ga[rt]); gx[rt] = MFMA16(a, bx, gx[rt]); } }
      const int chl = 16 * w + r, chg = n * 128 + chl; const float bav = c.lru_ba[chg], bxv = c.lru_bx[chg], sp = log1pf(expf(-c.lru_lam[chg]));
#pragma unroll
      for (int rt = 0; rt < 4; ++rt)
#pragma unroll
          for (int j = 0; j < 4; ++j) { const int t = 16 * rt + 4 * q + j; const float rr = sigmoidf_(ga[rt][j] + bav), ii = sigmoidf_(gx[rt][j] + bxv), la = -8.0f * rr * sp;
              AA[t * 128 + chl] = expf(la); UU[t * 128 + chl] = sqrtf(-expm1f(2.0f * la)) * ii * XC[t * 128 + chl]; }
    }
    __syncthreads();
    const int ch = tid & 127, sg = tid >> 7, chg = n * 128 + ch;
    { float A = 1.f, H = 0.f;
#pragma unroll 4
      for (int i = 0; i < 16; ++i) { const int t = sg * 16 + i; const float a = AA[t * 128 + ch]; H = a * H + UU[t * 128 + ch]; A *= a; }
      SEG[(sg * 128 + ch) * 2] = A; SEG[(sg * 128 + ch) * 2 + 1] = H;
      if (PASS2) { float CA = 1.f, CH = 0.f; const int per = (ck + 3) >> 2, lo = sg * per, hi = (lo + per < ck) ? lo + per : ck;
#pragma unroll 4
          for (int cc = lo; cc < hi; ++cc) { const float2 v = c.AGG[((size_t)b * 128 + cc) * 1024 + chg]; CH = v.x * CH + v.y; CA *= v.x; }
          SEG2[(sg * 128 + ch) * 2] = CA; SEG2[(sg * 128 + ch) * 2 + 1] = CH; }
    }
    __syncthreads();
    if (!PASS2) { if (tid < 128) { float A = 1.f, H = 0.f;
#pragma unroll
          for (int s = 0; s < 4; ++s) { const float a = SEG[(s * 128 + ch) * 2]; H = a * H + SEG[(s * 128 + ch) * 2 + 1]; A *= a; }
          c.AGG[((size_t)b * 128 + ck) * 1024 + chg] = make_float2(A, H); } }
    else { float H = 0.f;
#pragma unroll
        for (int s = 0; s < 4; ++s) H = SEG2[(s * 128 + ch) * 2] * H + SEG2[(s * 128 + ch) * 2 + 1];
        for (int s = 0; s < sg; ++s) H = SEG[(s * 128 + ch) * 2] * H + SEG[(s * 128 + ch) * 2 + 1];
#pragma unroll 4
        for (int i = 0; i < 16; ++i) { const int t = sg * 16 + i; H = AA[t * 128 + ch] * H + UU[t * 128 + ch];
            const float y = bf2f(c.P[(row0 + t) * NINP + C_LRUY + chg]); c.CAT[(row0 + t) * D + chg] = f2bf1(gelu_tanh(y) * H); } }
    __syncthreads();
}
__device__ __forceinline__ void vt_tile(const Ctx& c, LAS unsigned char* lds, int bt, int tid) {
    LAS bf16_t* TL = (LAS bf16_t*)lds;
    const size_t tok0 = (size_t)bt * 64; const int b = bt >> 7, s0 = (bt & 127) * 64;
#pragma unroll
    for (int i = 0; i < 4; ++i) { const int cidx = tid + 512 * i, row = cidx >> 5, chn = cidx & 31; const int col = (chn < 16) ? C_VS + chn * 8 : C_VW + (chn - 16) * 8;
        *(LAS u32x4*)(TL + row * 264 + chn * 8) = *(const u32x4*)(c.P + (tok0 + row) * NINP + col); }
    __syncthreads();
    { const int col = tid >> 1, half = tid & 1; bf16_t* dst = ((col < 128) ? c.VsT : c.VwT) + ((size_t)(b * 2 + ((col & 127) >> 6)) * 64 + (col & 63)) * S + s0 + half * 32;
#pragma unroll
      for (int k = 0; k < 4; ++k) { u32x4 o; unsigned v[8];
#pragma unroll
          for (int e = 0; e < 8; ++e) v[e] = TL[(half * 32 + k * 8 + e) * 264 + col];
          o.x = v[0] | (v[1] << 16); o.y = v[2] | (v[3] << 16); o.z = v[4] | (v[5] << 16); o.w = v[6] | (v[7] << 16); *(u32x4*)(dst + k * 8) = o; } }
    __syncthreads();
}
__device__ __forceinline__ void compress_task(const Ctx& c, LAS bf16_t* hid, int task, int lane) {
    const int nb = task & 31, g = (task >> 5) & 1, b = (task >> 6) & 1, kv = task >> 7, r = lane & 15, q = lane >> 4;
    int n = 16 * nb + r; if (n > 510) n = 510;
    const bf16_t* W1T = kv ? c.W1vT : c.W1kT; const bf16_t* W2T = kv ? c.W2vT : c.W2kT; const float* pe = kv ? c.pe_v : c.pe_k;
    const bf16_t* arow = c.P + ((size_t)b * S + 16 * n) * NINP + (kv ? C_VC : C_KC) + 64 * g;
    f32x4 acc[4];
#pragma unroll
    for (int i = 0; i < 4; ++i) acc[i] = (f32x4){0.f, 0.f, 0.f, 0.f};
#pragma unroll 4
    for (int ks = 0; ks < 64; ++ks) { const int l = ks >> 1, d0 = (ks & 1) * 32 + 8 * q;
        const u32x4 raw = *(const u32x4*)(arow + (size_t)l * NINP + d0); const f32x4 p0 = *(const f32x4*)(pe + l * 64 + d0), p1 = *(const f32x4*)(pe + l * 64 + d0 + 4);
        u32x4 o; o.x = pkbf(__uint_as_float(raw.x << 16) + p0[0], __uint_as_float(raw.x & 0xffff0000u) + p0[1]); o.y = pkbf(__uint_as_float(raw.y << 16) + p0[2], __uint_as_float(raw.y & 0xffff0000u) + p0[3]);
        o.z = pkbf(__uint_as_float(raw.z << 16) + p1[0], __uint_as_float(raw.z & 0xffff0000u) + p1[1]); o.w = pkbf(__uint_as_float(raw.w << 16) + p1[2], __uint_as_float(raw.w & 0xffff0000u) + p1[3]);
        const bf16x8 a = __builtin_bit_cast(bf16x8, o);
#pragma unroll
        for (int et = 0; et < 4; ++et) acc[et] = MFMA16(a, ld8(W1T + (size_t)(16 * et + r) * 2048 + 32 * ks + 8 * q), acc[et]); }
#pragma unroll
    for (int et = 0; et < 4; ++et)
#pragma unroll
        for (int j = 0; j < 4; ++j) hid[(4 * q + j) * 72 + 16 * et + r] = f2bf1(gelu_tanh(acc[et][j]));
    LDS_WAIT();
    f32x4 o2[4];
#pragma unroll
    for (int i = 0; i < 4; ++i) o2[i] = (f32x4){0.f, 0.f, 0.f, 0.f};
#pragma unroll
    for (int ks = 0; ks < 2; ++ks) { const bf16x8 a = *(const LAS bf16x8*)(hid + r * 72 + 32 * ks + 8 * q);
#pragma unroll
        for (int ft = 0; ft < 4; ++ft) o2[ft] = MFMA16(a, ld8(W2T + (16 * ft + r) * 64 + 32 * ks + 8 * q), o2[ft]); }
    LDS_WAIT();
#pragma unroll
    for (int ft = 0; ft < 4; ++ft)
#pragma unroll
        for (int j = 0; j < 4; ++j) { const int nn = 16 * nb + 4 * q + j; const float val = nn < 511 ? o2[ft][j] : 0.f;
            if (!kv) c.KCMP[((size_t)(b * 2 + g) * 512 + nn) * 64 + 16 * ft + r] = f2bf1(val); else c.VCMPT[((size_t)(b * 2 + g) * 64 + 16 * ft + r) * 512 + nn] = f2bf1(val); }
}
__device__ __forceinline__ void memkv_task(const Ctx& c, int task, int lane) {
    const int rt = task >> 6, ct = task & 63, r = lane & 15, q = lane >> 4; f32x4 acc = (f32x4){0.f, 0.f, 0.f, 0.f};
    const bf16_t* ap = c.MEMB + (size_t)(16 * rt + r) * 2048 + 8 * q; const bf16_t* bp = c.WmemT + (size_t)(16 * ct + r) * 2048 + 8 * q;
#pragma unroll 8
    for (int ks = 0; ks < 64; ++ks) acc = MFMA16(ld8(ap + 32 * ks), ld8(bp + 32 * ks), acc);
#pragma unroll
    for (int j = 0; j < 4; ++j) { const int row = 16 * rt + 4 * q + j;
        if (ct < 32) c.MK[(size_t)row * 512 + 16 * ct + r] = f2bf1(acc[j]); else c.MVT[((size_t)(row >> 8) * 512 + 16 * (ct - 32) + r) * 256 + (row & 255)] = f2bf1(acc[j]); }
}
__device__ __forceinline__ void nsa_item(const Ctx& c, LAS unsigned char* wl, LAS unsigned char* sl, int item, int lane) {
    const int qt = item & 511, g = (item >> 9) & 1, b = item >> 10, r = lane & 15, q = lane >> 4, t0 = 16 * qt, cur = qt >> 2;
    const size_t rowb = (size_t)b * S; const bf16_t* Pb = c.P + rowb * NINP;
    LAS float* impA = (LAS float*)wl; LAS float* impB = impA + 2048; LAS float* OACC = (LAS float*)wl; LAS float* GL = (LAS float*)(sl + 320);
    const f32x4 z4 = (f32x4){0.f, 0.f, 0.f, 0.f};
#pragma unroll
    for (int i = 0; i < 16; ++i) ((LAS f32x4*)wl)[lane + 64 * i] = z4;
#pragma unroll
    for (int i = 0; i < 3; ++i) { const int idx = lane + 64 * i, qi = idx / 12, k = idx - qi * 12; GL[idx] = sigmoidf_(bf2f(Pb[(size_t)(t0 + qi) * NINP + C_GATE + 12 * g + k])); }
    bf16x8 qf[4][2];
#pragma unroll
    for (int h = 0; h < 4; ++h)
#pragma unroll
        for (int ks = 0; ks < 2; ++ks) qf[h][ks] = scale8(ld8(Pb + (size_t)(t0 + r) * NINP + C_Q + (4 * g + h) * 64 + 32 * ks + 8 * q), 0.125f);
    const int nkt = (qt + 15) >> 4; const bf16_t* Kc = c.KCMP + (size_t)(b * 2 + g) * 512 * 64; const bf16_t* Vc = c.VCMPT + (size_t)(b * 2 + g) * 64 * 512;
    float m[4], l[4];
#pragma unroll
    for (int h = 0; h < 4; ++h) { m[h] = -1e30f; l[h] = 0.f; }
    for (int kt = 0; kt < nkt; ++kt) { const bf16x8 k0 = ld8(Kc + (16 * kt + r) * 64 + 8 * q), k1 = ld8(Kc + (16 * kt + r) * 64 + 32 + 8 * q);
#pragma unroll
        for (int h = 0; h < 4; ++h) { f32x4 s = MFMA16(k0, qf[h][0], z4); s = MFMA16(k1, qf[h][1], s); float tm = -1e30f; bool v[4];
#pragma unroll
            for (int j = 0; j < 4; ++j) { const int nk = 16 * kt + 4 * q + j; v[j] = (nk < qt - 1) || (nk == qt - 1 && r == 15); tm = fmaxf(tm, v[j] ? s[j] : -1e30f); }
            const float mn = fmaxf(m[h], tm); float ls = l[h] * __expf(m[h] - mn);
#pragma unroll
            for (int j = 0; j < 4; ++j) ls += v[j] ? __expf(s[j] - mn) : 0.f;
            l[h] = ls; m[h] = mn; } }
    float rl[4];
#pragma unroll
    for (int h = 0; h < 4; ++h) {
#pragma unroll
        for (int o = 16; o < 64; o <<= 1) { const float mo = __shfl_xor(m[h], o), lo = __shfl_xor(l[h], o), mn = fmaxf(m[h], mo); l[h] = l[h] * __expf(m[h] - mn) + lo * __expf(mo - mn); m[h] = mn; }
        rl[h] = l[h] > 0.f ? 1.0f / l[h] : 0.f; }
    f32x4 oc[4][4];
#pragma unroll
    for (int h = 0; h < 4; ++h)
#pragma unroll
        for (int dt = 0; dt < 4; ++dt) oc[h][dt] = z4;
    for (int kp = 0; kp < (nkt + 1) / 2; ++kp) { f32x4 pp[4][2];
#pragma unroll
        for (int hf = 0; hf < 2; ++hf) { const int kt = 2 * kp + hf;
            if (kt < nkt) { const bf16x8 k0 = ld8(Kc + (16 * kt + r) * 64 + 8 * q), k1 = ld8(Kc + (16 * kt + r) * 64 + 32 + 8 * q); f32x4 ps = z4;
#pragma unroll
                for (int h = 0; h < 4; ++h) { f32x4 s = MFMA16(k0, qf[h][0], z4); s = MFMA16(k1, qf[h][1], s);
#pragma unroll
                    for (int j = 0; j < 4; ++j) { const int nk = 16 * kt + 4 * q + j; const bool v = (nk < qt - 1) || (nk == qt - 1 && r == 15); s[j] = v ? __expf(s[j] - m[h]) * rl[h] : 0.f; }
                    pp[h][hf] = s; ps += s; }
                const int J = 4 * kt + q; impA[r * 128 + J] = (ps[0] + ps[1]) + (ps[2] + ps[3]); if (J + 1 < 128) impB[r * 128 + J + 1] = ps[3];
            } else {
#pragma unroll
                for (int h = 0; h < 4; ++h) pp[h][hf] = z4; } }
#pragma unroll
        for (int dt = 0; dt < 4; ++dt) { const bf16_t* vp = Vc + (16 * dt + r) * 512 + 32 * kp + 4 * q; const bf16x8 vf = join8(*(const u32x2*)vp, *(const u32x2*)(vp + 16));
#pragma unroll
            for (int h = 0; h < 4; ++h) oc[h][dt] = MFMA16(pack8(pp[h][0], pp[h][1]), vf, oc[h][dt]); } }
    LDS_WAIT();
    LAS unsigned char* selL = (LAS unsigned char*)sl;
    if (cur < 16) { for (int qi = 0; qi < 16; ++qi) { if (lane <= cur) selL[qi * 16 + lane] = (unsigned char)lane; if (lane == 0) selL[256 + qi] = (unsigned char)(cur + 1); } }
    else {
#pragma unroll
        for (int i = 0; i < 32; ++i) impA[lane + 64 * i] += impB[lane + 64 * i];
        LDS_WAIT();
        if (lane < 16) { impA[lane * 128] = 1e9f; impA[lane * 128 + cur] = 1e9f; impA[lane * 128 + cur - 1] = 1e9f; }
        LDS_WAIT();
        for (int qi = 0; qi < 16; ++qi) { const LAS float* iv = impA + qi * 128; const float v0 = iv[lane], v1 = iv[lane + 64]; int r0 = 0, r1 = 0;
            for (int i = 0; i <= cur; ++i) { const float vi = iv[i]; r0 += (vi > v0 || (vi == v0 && i < lane)) ? 1 : 0; r1 += (vi > v1 || (vi == v1 && i < lane + 64)) ? 1 : 0; }
            const bool s0 = (lane <= cur) && r0 < 16, s1 = (lane + 64 <= cur) && r1 < 16;
            const unsigned long long m0 = __ballot(s0), m1 = __ballot(s1), lt = (1ull << lane) - 1ull;
            if (s0) selL[qi * 16 + __popcll(m0 & lt)] = (unsigned char)lane;
            if (s1) selL[qi * 16 + __popcll(m0) + __popcll(m1 & lt)] = (unsigned char)(lane + 64);
            if (lane == 0) selL[256 + qi] = (unsigned char)(__popcll(m0) + __popcll(m1)); } }
    LDS_WAIT();
#pragma unroll
    for (int h = 0; h < 4; ++h)
#pragma unroll
        for (int dt = 0; dt < 4; ++dt)
#pragma unroll
            for (int j = 0; j < 4; ++j) OACC[((4 * q + j) * 4 + h) * 64 + 16 * dt + r] = GL[(4 * q + j) * 12 + 3 * h] * oc[h][dt][j];
    LDS_WAIT();
    const bf16_t* VsTb = c.VsT + (size_t)(b * 2 + g) * 64 * S;
    for (int qi = 0; qi < 16; ++qi) { const int t = t0 + qi, cnt = __builtin_amdgcn_readfirstlane((int)selL[256 + qi]);
        bf16x8 qs[2];
#pragma unroll
        for (int ks = 0; ks < 2; ++ks) qs[ks] = scale8(ld8(Pb + (size_t)t * NINP + C_Q + (4 * g + (r & 3)) * 64 + 32 * ks + 8 * q), 0.125f);
        float ms = -1e30f, lsum = 0.f; f32x4 os[4];
#pragma unroll
        for (int dt = 0; dt < 4; ++dt) os[dt] = z4;
        for (int bi = 0; bi < cnt; ++bi) { const int jb = __builtin_amdgcn_readfirstlane((int)selL[qi * 16 + bi]); const bf16_t* Kb = Pb + (size_t)(64 * jb) * NINP + C_KS + 64 * g; f32x4 s[4]; float tm = -1e30f;
#pragma unroll
            for (int k4 = 0; k4 < 4; ++k4) { const bf16_t* kp = Kb + (size_t)(16 * k4 + r) * NINP + 8 * q; s[k4] = MFMA16(ld8(kp), qs[0], z4); s[k4] = MFMA16(ld8(kp + 32), qs[1], s[k4]);
#pragma unroll
                for (int j = 0; j < 4; ++j) { if (64 * jb + 16 * k4 + 4 * q + j > t) s[k4][j] = -1e30f; tm = fmaxf(tm, s[k4][j]); } }
            tm = fmaxf(tm, __shfl_xor(tm, 16)); tm = fmaxf(tm, __shfl_xor(tm, 32));
            const float mn = fmaxf(ms, tm), al = __expf(ms - mn); ms = mn; float ps = 0.f;
#pragma unroll
            for (int k4 = 0; k4 < 4; ++k4)
#pragma unroll
                for (int j = 0; j < 4; ++j) { const float p = s[k4][j] > -1e29f ? __expf(s[k4][j] - mn) : 0.f; s[k4][j] = p; ps += p; }
            lsum = lsum * al + ps;
            const f32x4 av = (f32x4){rdlane(al, 0), rdlane(al, 1), rdlane(al, 2), rdlane(al, 3)};
#pragma unroll
            for (int dt = 0; dt < 4; ++dt) os[dt] *= av;
#pragma unroll
            for (int kp2 = 0; kp2 < 2; ++kp2) { const bf16x8 pa = pack8(s[2 * kp2], s[2 * kp2 + 1]);
#pragma unroll
                for (int dt = 0; dt < 4; ++dt) { const bf16_t* vp = VsTb + (size_t)(16 * dt + r) * S + 64 * jb + 32 * kp2 + 4 * q; os[dt] = MFMA16(pa, join8(*(const u32x2*)vp, *(const u32x2*)(vp + 16)), os[dt]); } } }
        lsum += __shfl_xor(lsum, 16); lsum += __shfl_xor(lsum, 32);
        const float l0 = rdlane(lsum, 0), l1 = rdlane(lsum, 1), l2 = rdlane(lsum, 2), l3 = rdlane(lsum, 3);
        const float lq = q == 0 ? l0 : q == 1 ? l1 : q == 2 ? l2 : l3; const float gsc = GL[qi * 12 + 3 * q + 1] / lq;
#pragma unroll
        for (int dt = 0; dt < 4; ++dt) { const float v = q == 0 ? os[dt][0] : q == 1 ? os[dt][1] : q == 2 ? os[dt][2] : os[dt][3]; OACC[(qi * 4 + q) * 64 + 16 * dt + r] += gsc * v; } }
    LDS_WAIT();
    float mw[4], lw[4]; f32x4 ow[4][4];
#pragma unroll
    for (int h = 0; h < 4; ++h) { mw[h] = -1e30f; lw[h] = 0.f;
#pragma unroll
        for (int dt = 0; dt < 4; ++dt) ow[h][dt] = z4; }
    const bf16_t* VwTb = c.VwT + (size_t)(b * 2 + g) * 64 * S; const int tq = t0 + r;
    for (int ip = 0; ip < 17; ++ip) { const int ke = t0 - 512 + 32 * ip; if (ke + 16 < 0) continue; f32x4 pp[4][2];
#pragma unroll
        for (int hf = 0; hf < 2; ++hf) { const int k0t = ke + 16 * hf;
            if (k0t >= 0 && k0t <= t0) { const bf16_t* kp = Pb + (size_t)(k0t + r) * NINP + C_KW + 64 * g + 8 * q; const bf16x8 k0 = ld8(kp), k1 = ld8(kp + 32);
#pragma unroll
                for (int h = 0; h < 4; ++h) { f32x4 s = MFMA16(k0, qf[h][0], z4); s = MFMA16(k1, qf[h][1], s);
#pragma unroll
                    for (int j = 0; j < 4; ++j) { const int kk = k0t + 4 * q + j; if (kk > tq || kk <= tq - 512) s[j] = -1e30f; }
                    pp[h][hf] = s; }
            } else {
#pragma unroll
                for (int h = 0; h < 4; ++h) pp[h][hf] = (f32x4){-1e30f, -1e30f, -1e30f, -1e30f}; } }
        bf16x8 pa[4];
#pragma unroll
        for (int h = 0; h < 4; ++h) { float tm = -1e30f;
#pragma unroll
            for (int j = 0; j < 4; ++j) tm = fmaxf(tm, fmaxf(pp[h][0][j], pp[h][1][j]));
            tm = fmaxf(tm, __shfl_xor(tm, 16)); tm = fmaxf(tm, __shfl_xor(tm, 32));
            const float mn = fmaxf(mw[h], tm), al = __expf(mw[h] - mn); mw[h] = mn; float ps = 0.f;
#pragma unroll
            for (int hf = 0; hf < 2; ++hf)
#pragma unroll
                for (int j = 0; j < 4; ++j) { const float p = pp[h][hf][j] > -1e29f ? __expf(pp[h][hf][j] - mn) : 0.f; pp[h][hf][j] = p; ps += p; }
            lw[h] = lw[h] * al + ps;
            const f32x4 av = (f32x4){__shfl(al, 4 * q), __shfl(al, 4 * q + 1), __shfl(al, 4 * q + 2), __shfl(al, 4 * q + 3)};
#pragma unroll
            for (int dt = 0; dt < 4; ++dt) ow[h][dt] *= av;
            pa[h] = pack8(pp[h][0], pp[h][1]); }
        const int kce = ke < 0 ? 0 : ke, kco = (ke + 16 > t0) ? t0 : ke + 16;
#pragma unroll
        for (int dt = 0; dt < 4; ++dt) { const bf16_t* vp = VwTb + (size_t)(16 * dt + r) * S + 4 * q; const bf16x8 vf = join8(*(const u32x2*)(vp + kce), *(const u32x2*)(vp + kco));
#pragma unroll
            for (int h = 0; h < 4; ++h) ow[h][dt] = MFMA16(pa[h], vf, ow[h][dt]); } }
#pragma unroll
    for (int h = 0; h < 4; ++h) { lw[h] += __shfl_xor(lw[h], 16); lw[h] += __shfl_xor(lw[h], 32);
        const f32x4 lr = (f32x4){__shfl(lw[h], 4 * q), __shfl(lw[h], 4 * q + 1), __shfl(lw[h], 4 * q + 2), __shfl(lw[h], 4 * q + 3)};
#pragma unroll
        for (int dt = 0; dt < 4; ++dt)
#pragma unroll
            for (int j = 0; j < 4; ++j) { const int qi = 4 * q + j; const float val = OACC[(qi * 4 + h) * 64 + 16 * dt + r] + GL[qi * 12 + 3 * h + 2] * ow[h][dt][j] / lr[j];
                c.CAT[(rowb + t0 + qi) * D + 1024 + (4 * g + h) * 64 + 16 * dt + r] = f2bf1(val); } }
    LDS_WAIT();
}
__device__ __forceinline__ void mem_item(const Ctx& c, int item, int lane) {
    const int qt = item & 511, h = (item >> 9) & 3, b = item >> 11, r = lane & 15, q = lane >> 4; const size_t rowb = (size_t)b * S + 16 * qt;
    const f32x4 z4 = (f32x4){0.f, 0.f, 0.f, 0.f};
    bf16x8 qm[4];
#pragma unroll
    for (int ks = 0; ks < 4; ++ks) qm[ks] = ld8(c.P + (rowb + r) * NINP + C_MQ + 128 * h + 32 * ks + 8 * q);
    f32x4 s[16]; float mx = -1e30f;
#pragma unroll
    for (int kt = 0; kt < 16; ++kt) { s[kt] = z4; const bf16_t* kp = c.MK + (size_t)(b * 256 + 16 * kt + r) * 512 + 128 * h + 8 * q;
#pragma unroll
        for (int ks = 0; ks < 4; ++ks) s[kt] = MFMA16(ld8(kp + 32 * ks), qm[ks], s[kt]);
        s[kt] *= 0.08838834764831845f;
#pragma unroll
        for (int j = 0; j < 4; ++j) mx = fmaxf(mx, s[kt][j]); }
    mx = fmaxf(mx, __shfl_xor(mx, 16)); mx = fmaxf(mx, __shfl_xor(mx, 32)); float ls = 0.f;
#pragma unroll
    for (int kt = 0; kt < 16; ++kt)
#pragma unroll
        for (int j = 0; j < 4; ++j) { s[kt][j] = __expf(s[kt][j] - mx); ls += s[kt][j]; }
    ls += __shfl_xor(ls, 16); ls += __shfl_xor(ls, 32);
    f32x4 o[8];
#pragma unroll
    for (int dt = 0; dt < 8; ++dt) o[dt] = z4;
#pragma unroll
    for (int kp = 0; kp < 8; ++kp) { const bf16x8 pa = pack8(s[2 * kp], s[2 * kp + 1]);
#pragma unroll
        for (int dt = 0; dt < 8; ++dt) { const bf16_t* vp = c.MVT + ((size_t)b * 512 + 128 * h + 16 * dt + r) * 256 + 32 * kp + 4 * q; o[dt] = MFMA16(pa, join8(*(const u32x2*)vp, *(const u32x2*)(vp + 16)), o[dt]); } }
    const f32x4 lr = (f32x4){__shfl(ls, 4 * q), __shfl(ls, 4 * q + 1), __shfl(ls, 4 * q + 2), __shfl(ls, 4 * q + 3)};
#pragma unroll
    for (int dt = 0; dt < 8; ++dt)
#pragma unroll
        for (int j = 0; j < 4; ++j) c.CAT[(rowb + 4 * q + j) * D + 1536 + 128 * h + 16 * dt + r] = f2bf1(o[dt][j] / lr[j]);
}
__global__ void __launch_bounds__(512, 2) hymba_fwd(Args a) {
    extern __shared__ __attribute__((aligned(16))) unsigned char lds_raw[];
    LAS unsigned char* lds = (LAS unsigned char*)lds_raw;
    cg::grid_group grid = cg::this_grid();
    Ctx c;
    c.x = a.in[0]; c.mem = a.in[1]; c.ln_in_g = a.in[2]; c.ln_in_b = a.in[3]; c.w_in = a.in[4]; c.lru_cw = a.in[5]; c.lru_cb = a.in[6]; c.lru_wa = a.in[7]; c.lru_ba = a.in[8]; c.lru_wx = a.in[9]; c.lru_bx = a.in[10];
    c.lru_lam = a.in[11]; c.pe_k = a.in[12]; c.w1k = a.in[13]; c.w2k = a.in[14]; c.pe_v = a.in[15]; c.w1v = a.in[16]; c.w2v = a.in[17]; c.w_mem = a.in[18]; c.w_out = a.in[19]; c.ln1_g = a.in[20]; c.ln1_b = a.in[21];
    c.w_up = a.in[22]; c.fcw = a.in[23]; c.fcb = a.in[24]; c.w_down = a.in[25]; c.ln2_g = a.in[26]; c.ln2_b = a.in[27]; c.out = a.out;
    unsigned char* ws = a.ws;
    c.WinT = (bf16_t*)(ws + WS_WIN); c.WoutT = (bf16_t*)(ws + WS_WOUT); c.WupT = (bf16_t*)(ws + WS_WUP); c.WdownT = (bf16_t*)(ws + WS_WDOWN); c.WmemT = (bf16_t*)(ws + WS_WMEM); c.MEMB = (bf16_t*)(ws + WS_MEMB);
    c.WaT = (bf16_t*)(ws + WS_WAT); c.WxT = (bf16_t*)(ws + WS_WXT); c.W1kT = (bf16_t*)(ws + WS_W1K); c.W1vT = (bf16_t*)(ws + WS_W1V); c.W2kT = (bf16_t*)(ws + WS_W2K); c.W2vT = (bf16_t*)(ws + WS_W2V);
    c.MK = (bf16_t*)(ws + WS_MK); c.MVT = (bf16_t*)(ws + WS_MVT); c.KCMP = (bf16_t*)(ws + WS_KCMP); c.VCMPT = (bf16_t*)(ws + WS_VCMPT); c.AGG = (float2*)(ws + WS_AGG); c.VsT = (bf16_t*)(ws + WS_VST); c.VwT = (bf16_t*)(ws + WS_VWT);
    c.H0F = (float*)(ws + WS_H0F); c.H0B = (bf16_t*)(ws + WS_H0B); c.P = (bf16_t*)(ws + WS_P); c.CAT = (bf16_t*)(ws + WS_CAT); c.H1B = (bf16_t*)(ws + WS_H1B); c.ACT = (bf16_t*)(ws + WS_ACT);
    const int tid = threadIdx.x, lane = tid & 63, wave = __builtin_amdgcn_readfirstlane(tid >> 6), G = gridDim.x, gw = blockIdx.x * 8 + wave, NGW = G * 8;
    const int lo = a.ph_lo, hi = a.ph_hi;
#define IN(k) (lo <= (k) && (k) < hi)
#define SEAM(k) do { if (IN(k) && IN((k) + 1)) grid.sync(); } while (0)
    if (IN(0)) phase0(c, lds, gw, NGW, wave, lane);
    SEAM(0);
    if (IN(1)) { pg8::Gemm g{c.H0B, c.WinT, T, NINP, D, 0}; pg8::StaticOrder so; so.init(T, NINP, G, (int)blockIdx.x); pg8::EpiBf16<0> E{c.P, NINP, nullptr, 0, 0};
        pg8::gemm_phase<pg8::EpiBf16<0>, pg8::StaticOrder, false>(lds, g, so, E, nullptr); }
    SEAM(1);
    if (IN(2)) {
        for (int bt = blockIdx.x; bt < 256; bt += G) vt_tile(c, lds, bt, tid);
        for (int tile = blockIdx.x; tile < 2048; tile += G) lru_tile<false>(c, lds, tile, tid);
        for (int task = gw; task < 2048; task += NGW) memkv_task(c, task, lane);
        if (wave == 0) for (int task = blockIdx.x; task < 256; task += G) compress_task(c, (LAS bf16_t*)lds, task, lane);
    }
    SEAM(2);
    if (IN(3)) {
        for (int tile = blockIdx.x; tile < 2048; tile += G) lru_tile<true>(c, lds, tile, tid);
        for (int item = gw; item < 2048; item += NGW) nsa_item(c, lds + wave * 16384, lds + 131072 + wave * 1280, item, lane);
        for (int item = gw; item < 4096; item += NGW) mem_item(c, item, lane);
    }
    SEAM(3);
    if (IN(4)) { pg8::Gemm g{c.CAT, c.WoutT, T, D, D, 0}; pg8::StaticOrder so; so.init(T, D, G, (int)blockIdx.x); pg8::EpiResF32 E{c.out, c.H0F, D, ALPHA};
        pg8::gemm_phase<pg8::EpiResF32, pg8::StaticOrder, false>(lds, g, so, E, nullptr); }
    SEAM(4);
    if (IN(5)) { for (int m = gw; m < T; m += NGW) ln_row(c.out + (size_t)m * D, c.ln1_g, c.ln1_b, c.out + (size_t)m * D, c.H1B + (size_t)m * D, lane); }
    SEAM(5);
    if (IN(6)) { pg8::Gemm g{c.H1B, c.WupT, 66 * 256, 2 * DFF, D, 1}; pg8::StaticOrder so; so.init(66 * 256, 2 * DFF, G, (int)blockIdx.x); pg8::EpiConvGeglu E{c.ACT, c.fcw, c.fcb, (LAS float*)(lds + EX_OFF)};
        pg8::gemm_phase<pg8::EpiConvGeglu, pg8::StaticOrder, false>(lds, g, so, E, nullptr); }
    SEAM(6);
    if (IN(7)) { pg8::Gemm g{c.ACT, c.WdownT, T, D, DFF, 0}; pg8::StaticOrder so; so.init(T, D, G, (int)blockIdx.x); pg8::EpiResF32 E{c.out, c.out, D, ALPHA};
        pg8::gemm_phase<pg8::EpiResF32, pg8::StaticOrder, false>(lds, g, so, E, nullptr); }
    SEAM(7);
    if (IN(8)) { for (int m = gw; m < T; m += NGW) ln_row(c.out + (size_t)m * D, c.ln2_g, c.ln2_b, c.out + (size_t)m * D, nullptr, lane); }
#undef IN
#undef SEAM
}

extern "C" void kernel_launch(void* const* d_in, const int* in_sizes, int n_in, void* d_out, int out_size, void* d_ws, size_t ws_size, hipStream_t stream) {
    static int grid = 0;
    if (grid == 0) {
        if (n_in != 28 || out_size != T * D || ws_size < WS_END) { fprintf(stderr, "kernel_launch: unexpected shapes (n_in %d, out %d, ws %zu)\n", n_in, out_size, ws_size); grid = -1; return; }
        int dev = 0, cus = 0, per_cu = 0;
        (void)hipGetDevice(&dev); (void)hipDeviceGetAttribute(&cus, hipDeviceAttributeMultiprocessorCount, dev);
        if (hipFuncSetAttribute((const void*)hymba_fwd, hipFuncAttributeMaxDynamicSharedMemorySize, LDS_BYTES) != hipSuccess) { fprintf(stderr, "kernel_launch: hipFuncSetAttribute failed\n"); grid = -1; return; }
        if (hipOccupancyMaxActiveBlocksPerMultiprocessor(&per_cu, (const void*)hymba_fwd, 512, LDS_BYTES) != hipSuccess || per_cu < 1) per_cu = 1;
        (void)hipGetLastError();
        grid = cus * per_cu;
        fprintf(stderr, "kernel_launch: grid %d (cus %d x %d)\n", grid, cus, per_cu);
    }
    if (grid < 0) return;
    Args a{};
    for (int i = 0; i < 28; ++i) a.in[i] = (const float*)d_in[i];
    a.out = (float*)d_out; a.ws = (unsigned char*)d_ws; a.ph_lo = 0; a.ph_hi = 9;
    void* args[] = {&a};
    const hipError_t e = hipLaunchCooperativeKernel((void*)hymba_fwd, dim3(grid), dim3(512), args, LDS_BYTES, stream);
    if (e != hipSuccess) fprintf(stderr, "kernel_launch: cooperative launch failed: %s (grid %d)\n", hipGetErrorString(e), grid);
}
```

```cpp
#include <hip/hip_runtime.h>
#include <hip/hip_cooperative_groups.h>
#include <cstdio>
namespace cg = cooperative_groups;
namespace pg8 {
#define PG8_LAS __attribute__((address_space(3)))
typedef unsigned short bf16_t;
typedef short bf16x8 __attribute__((ext_vector_type(8)));
typedef float f32x4 __attribute__((ext_vector_type(4)));
typedef unsigned u32x4 __attribute__((ext_vector_type(4)));
constexpr int BM = 256, BK = 64, HALF = 128, HTB = HALF * BK * 2  , STAGE_BYTES = 8 * HTB, NXCD = 8, WGM = 4;

__host__ __device__ __forceinline__ int lds_byte(int r, int c) { const int st = (r >> 4) * 2 + (c >> 5), rr = r & 15, cc = c & 31, ob = rr * 64 + cc * 2; return st * 1024 + (ob ^ (((ob >> 9) & 1) << 5)); }
__host__ __device__ __forceinline__ void stage_rc(int b, int& R, int& C) { const int st = b / 1024, sb = b % 1024, swz = sb ^ (((sb >> 9) & 1) << 5); R = (st >> 1) * 16 + swz / 64; C = (st & 1) * 32 + (swz % 64) / 2; }
__host__ __device__ __forceinline__ int perm32(int rho) { const int n = rho >> 4, i = rho & 15; return 8 * (i >> 2) + 4 * n + (i & 3); }

struct Unit { int pm, pn; };
struct Gemm { const bf16_t* A; const bf16_t* Bt; int M, N, K; int halo; };
__device__ __forceinline__ long long a_off(const Gemm& g, int pm) { return g.halo ? ((long long)((pm / 33) * 8192 + (pm % 33) * 254 - 2) * g.K * 2) : ((long long)pm * 256 * g.K * 2); }

struct StaticOrder {
    int nM, nN, nwg, G, c, wgm;
    __host__ __device__ void init(int M, int N, int G_, int c_, int wgm_ = WGM) { nM = M / BM; nN = N / BM; nwg = nM * nN; G = G_; c = c_; wgm = wgm_; }
    __host__ __device__ bool next(int i, Unit& u) const {
        const long L = (long)i * G + c; if (L >= nwg) return false;
        int wgid = (int)L; { const int q = nwg / NXCD, r = nwg % NXCD, xcd = wgid % NXCD, off = wgid / NXCD; wgid = (xcd < r ? xcd * (q + 1) : r * (q + 1) + (xcd - r) * q) + off; }
        const int nig = wgm * nN, gid = wgid / nig, fm = gid * wgm, gsz = (nM - fm) < wgm ? (nM - fm) : wgm;
        u.pm = fm + ((wgid % nig) % gsz); u.pn = (wgid % nig) / gsz; return true;
    }
    __device__ __forceinline__ void a_ready(const Unit&) const {}
    __device__ __forceinline__ void done(const Unit&) const {}
};
__device__ __forceinline__ unsigned cvt_pk_bf16(float lo, float hi) { unsigned r; asm volatile("v_cvt_pk_bf16_f32 %0, %1, %2" : "=v"(r) : "v"(lo), "v"(hi)); return r; }
typedef float f32x2 __attribute__((ext_vector_type(2)));
__device__ __forceinline__ f32x2 gelu_pk(f32x2 v) {
    const f32x2 av = __builtin_elementwise_abs(v), d = av * 0.2316418882f + 1.0f;
    f32x2 t; t.x = __builtin_amdgcn_rcpf(d.x); t.y = __builtin_amdgcn_rcpf(d.y);
    f32x2 q = t * 0.5307027145f + (-0.7265760135f); q = q * t + 0.7107068705f; q = q * t + (-0.142248368f); q = q * t + 0.127414796f; q = q * t;
    const f32x2 s = (v * v) * (-0.72134752044f);
    f32x2 e; e.x = __builtin_amdgcn_exp2f(s.x); e.y = __builtin_amdgcn_exp2f(s.y);
    const f32x2 m = v * (q * e), r = v - m;
    f32x2 o; o.x = v.x < 0.f ? m.x : r.x; o.y = v.y < 0.f ? m.y : r.y; return o;
}

template <int ACT  > struct EpiBf16 {
    static constexpr bool PERM = true, AFTER_DRAIN = false;
    bf16_t* O; int ldc; const float* bias; int split_cols; size_t split_stride;
    __device__ __forceinline__ void operator()(const f32x4 (&acc)[2][2][4][2], const Unit& u, int wr, int wc, int fr, int fq) const {
        const int row0 = u.pm * BM + wr * 64 + fr; int colt = u.pn * BM; bf16_t* base = O;
        if (split_cols) { const int t = colt / split_cols; base += (size_t)t * split_stride; colt -= t * split_cols; }
        const int col0 = colt + wc * 32 + 8 * fq, bcol0 = u.pn * BM + wc * 32 + 8 * fq;
        f32x4 bv[2][2];
#pragma unroll
        for (int bj = 0; bj < 2; ++bj)
#pragma unroll
            for (int n = 0; n < 2; ++n) bv[bj][n] = bias ? *(const f32x4*)(bias + bcol0 + bj * HALF + 4 * n) : (f32x4){0.f, 0.f, 0.f, 0.f};
#pragma unroll
        for (int ai = 0; ai < 2; ++ai)
#pragma unroll
            for (int m = 0; m < 4; ++m) { bf16_t* rowp = base + (size_t)(row0 + ai * HALF + m * 16) * ldc + col0;
#pragma unroll
                for (int bj = 0; bj < 2; ++bj) { f32x4 v0 = acc[ai][bj][m][0] + bv[bj][0], v1 = acc[ai][bj][m][1] + bv[bj][1];
                    if (ACT == 1) { f32x2 a = gelu_pk((f32x2){v0[0], v0[1]}), b = gelu_pk((f32x2){v0[2], v0[3]}), c = gelu_pk((f32x2){v1[0], v1[1]}), d = gelu_pk((f32x2){v1[2], v1[3]});
                        v0 = (f32x4){a.x, a.y, b.x, b.y}; v1 = (f32x4){c.x, c.y, d.x, d.y}; }
                    if (ACT == 2) {
#pragma unroll
                        for (int j = 0; j < 4; ++j) { v0[j] = 0.5f * v0[j] * (1.0f + erff(v0[j] * 0.70710678f)); v1[j] = 0.5f * v1[j] * (1.0f + erff(v1[j] * 0.70710678f)); } }
                    u32x4 w; w.x = cvt_pk_bf16(v0[0], v0[1]); w.y = cvt_pk_bf16(v0[2], v0[3]); w.z = cvt_pk_bf16(v1[0], v1[1]); w.w = cvt_pk_bf16(v1[2], v1[3]);
                    *(u32x4*)(rowp + bj * HALF) = w; } }
    }
};
struct EpiResF32 {
    static constexpr bool PERM = false, AFTER_DRAIN = false;
    float* C; const float* base; int ldc; float alpha;
    __device__ __forceinline__ void operator()(const f32x4 (&acc)[2][2][4][2], const Unit& u, int wr, int wc, int fr, int fq) const {
        const int row0 = u.pm * BM + wr * 64 + fr, col0 = u.pn * BM + wc * 32 + 4 * fq;
#pragma unroll
        for (int ai = 0; ai < 2; ++ai)
#pragma unroll
            for (int m = 0; m < 4; ++m) { const size_t off = (size_t)(row0 + ai * HALF + m * 16) * ldc + col0;
#pragma unroll
                for (int bj = 0; bj < 2; ++bj)
#pragma unroll
                    for (int n = 0; n < 2; ++n) { const f32x4 bs = *(const f32x4*)(base + off + bj * HALF + n * 16); *(f32x4*)(C + off + bj * HALF + n * 16) = bs * alpha + acc[ai][bj][m][n]; } }
    }
};
struct EpiResLnF32 {
    static constexpr bool PERM = false, AFTER_DRAIN = false;
    float* C; const float* base; const float2* stats; const float* g; const float* b; int ldc; float alpha;
    __device__ __forceinline__ void operator()(const f32x4 (&acc)[2][2][4][2], const Unit& u, int wr, int wc, int fr, int fq) const {
        const int row0 = u.pm * BM + wr * 64 + fr, col0 = u.pn * BM + wc * 32 + 4 * fq;
        f32x4 gv[2][2], bv[2][2];
#pragma unroll
        for (int bj = 0; bj < 2; ++bj)
#pragma unroll
            for (int n = 0; n < 2; ++n) { gv[bj][n] = *(const f32x4*)(g + col0 + bj * HALF + n * 16) * alpha; bv[bj][n] = *(const f32x4*)(b + col0 + bj * HALF + n * 16) * alpha; }
#pragma unroll
        for (int ai = 0; ai < 2; ++ai)
#pragma unroll
            for (int m = 0; m < 4; ++m) { const int row = row0 + ai * HALF + m * 16; const size_t off = (size_t)row * ldc + col0; const float2 st = stats[row];
#pragma unroll
                for (int bj = 0; bj < 2; ++bj)
#pragma unroll
                    for (int n = 0; n < 2; ++n) { const f32x4 bs = *(const f32x4*)(base + off + bj * HALF + n * 16); *(f32x4*)(C + off + bj * HALF + n * 16) = ((bs - st.x) * st.y) * gv[bj][n] + bv[bj][n] + acc[ai][bj][m][n]; } }
    }
};
template <int CTRL> __device__ __forceinline__ float dppf(float old, float src) {
    return __builtin_bit_cast(float, __builtin_amdgcn_update_dpp(__builtin_bit_cast(int, old), __builtin_bit_cast(int, src), CTRL, 0xf, 0xf, false));
}
__device__ __forceinline__ float gelu_tanh(float x) {
    const float u = 1.5957691216f * (x + 0.044715f * x * x * x);
    return x * __builtin_amdgcn_rcpf(1.0f + __expf(-u));
}
struct EpiConvGeglu {
    static constexpr bool PERM = true, AFTER_DRAIN = false;
    bf16_t* ACT; const float* cw; const float* cb; PG8_LAS float* EX;
    __device__ __forceinline__ void operator()(const f32x4 (&acc)[2][2][4][2], const Unit& u, int wr, int wc, int fr, int fq) const {
        const int b = u.pm / 33, j = u.pm % 33, colu = wc * 32 + 8 * fq;
        if (fr >= 14) {
#pragma unroll
            for (int ai = 0; ai < 2; ++ai)
#pragma unroll
                for (int bj = 0; bj < 2; ++bj)
#pragma unroll
                    for (int n = 0; n < 2; ++n) *(PG8_LAS f32x4*)(EX + ((ai * 2 + wr) * 2 + (fr - 14)) * 256 + bj * 128 + colu + 4 * n) = acc[ai][bj][3][n];
        }
        f32x4 wgs[2][3], wus[2][3], bgs[2], bus[2];
#define CG_LOADP(N_) do { const int ca_ = u.pn * 128 + colu + 4 * (N_); _Pragma("unroll") for (int k = 0; k < 3; ++k) { wgs[N_][k] = *(const f32x4*)(cw + k * 11264 + ca_); wus[N_][k] = *(const f32x4*)(cw + k * 11264 + 5632 + ca_); } \
            bgs[N_] = *(const f32x4*)(cb + ca_); bus[N_] = *(const f32x4*)(cb + 5632 + ca_); } while (0)
        CG_LOADP(0); CG_LOADP(1);
        asm volatile("s_waitcnt lgkmcnt(0)" ::: "memory"); __builtin_amdgcn_s_barrier(); __builtin_amdgcn_s_barrier(); asm volatile("" ::: "memory");
        const int tb = j * 254 - 2; const bool zr = (j == 0) && (wr == 0) && (fr < 2);
        const f32x4 z4 = (f32x4){0.f, 0.f, 0.f, 0.f};
        const int ca = u.pn * 128 + colu;
#pragma unroll
        for (int ai = 0; ai < 2; ++ai) {
            f32x4 pg[2], pu[2];
#pragma unroll
            for (int n = 0; n < 2; ++n) { pg[n] = z4; pu[n] = z4;
                if (!(ai == 0 && wr == 0)) { const int slot = (wr == 1) ? (ai * 2) : ((ai - 1) * 2 + 1);
                    pg[n] = *(const PG8_LAS f32x4*)(EX + (slot * 2 + (fr & 1)) * 256 + colu + 4 * n); pu[n] = *(const PG8_LAS f32x4*)(EX + (slot * 2 + (fr & 1)) * 256 + 128 + colu + 4 * n); } }
#pragma unroll
            for (int m = 0; m < 4; ++m) { u32x4 w;
#pragma unroll
                for (int n = 0; n < 2; ++n) {
                    f32x4 xg = acc[ai][0][m][n], xu = acc[ai][1][m][n];
                    if (ai == 0 && m == 0 && zr) { xg = z4; xu = z4; }
                    f32x4 g1, g2, u1, u2;
#pragma unroll
                    for (int e = 0; e < 4; ++e) { g1[e] = dppf<0x111>(dppf<0x121>(0.f, pg[n][e]), xg[e]); g2[e] = dppf<0x112>(dppf<0x122>(0.f, pg[n][e]), xg[e]);
                        u1[e] = dppf<0x111>(dppf<0x121>(0.f, pu[n][e]), xu[e]); u2[e] = dppf<0x112>(dppf<0x122>(0.f, pu[n][e]), xu[e]); }
                    const f32x4 cg = bgs[n] + wgs[n][0] * g2 + wgs[n][1] * g1 + wgs[n][2] * xg, cu = bus[n] + wus[n][0] * u2 + wus[n][1] * u1 + wus[n][2] * xu;
                    const f32x4 zz = cg * ((cg * cg) * 0.10294324f + 2.3022082f);
                    f32x4 dn;
#pragma unroll
                    for (int e = 0; e < 4; ++e) dn[e] = __builtin_amdgcn_exp2f(-zz[e]);
                    dn = dn + 1.0f;
#pragma unroll
                    for (int e = 0; e < 4; ++e) dn[e] = __builtin_amdgcn_rcpf(dn[e]);
                    const f32x4 a4 = (cg * cu) * dn;
                    pg[n] = xg; pu[n] = xu;
                    if (n == 0) { w.x = cvt_pk_bf16(a4[0], a4[1]); w.y = cvt_pk_bf16(a4[2], a4[3]); } else { w.z = cvt_pk_bf16(a4[0], a4[1]); w.w = cvt_pk_bf16(a4[2], a4[3]); }
                }
                const int tr = ai * 128 + wr * 64 + m * 16 + fr, t = tb + tr;
                if (tr >= 2 && t < 8192) *(u32x4*)(ACT + (size_t)(b * 8192 + t) * 5632 + ca) = w;
            }
        }
#undef CG_LOADP
    }
};
template <class Epi, class Sched, bool STAMP = false>
__device__ __forceinline__ void gemm_phase(PG8_LAS unsigned char* lds, const Gemm g, const Sched& S, const Epi& E, unsigned long long* stamps) {
    const int tid = threadIdx.x, wid = __builtin_amdgcn_readfirstlane(tid >> 6), lane = tid & 63, wr = wid >> 2, wc = wid & 3, fr = lane & 15, fq = lane >> 4;
    const int K = g.K, nt = K / BK;
    int ts_lo = 0, ts_hi = 0, nts = 0; const unsigned long long rt_entry = STAMP ? (unsigned long long)wall_clock64() : 0ull;
#define PG8_STAMP() do { if (STAMP && wid == 0 && nts < 64) { const unsigned long long _c = (unsigned long long)clock64(); \
        ts_lo = (lane == nts) ? (int)(unsigned)_c : ts_lo; ts_hi = (lane == nts) ? (int)(unsigned)(_c >> 32) : ts_hi; ++nts; } } while (0)
    PG8_STAMP();
    unsigned voffA[2], voffB[2];
#pragma unroll
    for (int i = 0; i < 2; ++i) { int R, C; stage_rc(tid * 16 + i * 8192, R, C); const int Rb = Epi::PERM ? ((R & ~31) + perm32(R & 31)) : R;
        voffA[i] = (unsigned)(R * K + C) * 2u; voffB[i] = (unsigned)(Rb * K + C) * 2u; }
    const size_t kstep = (size_t)(BK * 2);
    const size_t hstep = (size_t)HALF * K * 2;
    const size_t tstep = 2 * hstep;
    const unsigned ldsw = (unsigned)wid * 1024u;
    const int aoff = lds_byte(wr * 64 + fr, fq * 8), boff = lds_byte(wc * 32 + fr, fq * 8);
#define PG8_SA(b, h) (((b) * 2 + (h)) * HTB)
#define PG8_SB(b, h) ((4 + (b) * 2 + (h)) * HTB)
#define PG8_STAGE(bufoff, gbase, voff) do { _Pragma("unroll") for (int _i = 0; _i < 2; ++_i) \
        __builtin_amdgcn_global_load_lds((const unsigned*)((const char*)(gbase) + (voff)[_i]), (PG8_LAS unsigned*)(lds + (bufoff) + ldsw + _i * 8192), 16, 0, 0); } while (0)
#define PG8_LDA(dst, b, h) do { _Pragma("unroll") for (int m = 0; m < 4; ++m) _Pragma("unroll") for (int k = 0; k < 2; ++k) dst[m][k] = *(const PG8_LAS bf16x8*)(lds + PG8_SA(b, h) + aoff + m * 2048 + k * 1024); } while (0)
#define PG8_LDB(dst, b, h) do { _Pragma("unroll") for (int n = 0; n < 2; ++n) _Pragma("unroll") for (int k = 0; k < 2; ++k) dst[n][k] = *(const PG8_LAS bf16x8*)(lds + PG8_SB(b, h) + boff + n * 2048 + k * 1024); } while (0)
#define PG8_MMA(ai, bj, At, Bt) do { __builtin_amdgcn_s_setprio(1); _Pragma("unroll") for (int m = 0; m < 4; ++m) _Pragma("unroll") for (int n = 0; n < 2; ++n) _Pragma("unroll") for (int k = 0; k < 2; ++k) \
        acc[ai][bj][m][n] = __builtin_amdgcn_mfma_f32_16x16x32_bf16(Bt[n][k], At[m][k], acc[ai][bj][m][n], 0, 0, 0); __builtin_amdgcn_s_setprio(0); } while (0)
#define PG8_WAIT_V(n) asm volatile("s_waitcnt vmcnt(" #n ")" ::: "memory")
#define PG8_WAIT_L(n) asm volatile("s_waitcnt lgkmcnt(" #n ")" ::: "memory")
#define PG8_BAR __builtin_amdgcn_s_barrier()
#define PG8_SCHED __builtin_amdgcn_sched_barrier(0)
    Unit cur, nxt; int ui = 0;
    if (!S.next(0, cur)) return;
    f32x4 acc[2][2][4][2];
#pragma unroll
    for (int a = 0; a < 2; ++a)
#pragma unroll
        for (int b = 0; b < 2; ++b)
#pragma unroll
            for (int m = 0; m < 4; ++m)
#pragma unroll
                for (int n = 0; n < 2; ++n) acc[a][b][m][n] = (f32x4){0.f, 0.f, 0.f, 0.f};
    bf16x8 At[4][2], B0[2][2], B1[2][2];
    const char* cA = (const char*)g.A + a_off(g, cur.pm); const char* cB = (const char*)g.Bt + (size_t)cur.pn * tstep;
    S.a_ready(cur);
    PG8_STAGE(PG8_SB(0, 0), cB, voffB); PG8_STAGE(PG8_SA(0, 0), cA, voffA); PG8_STAGE(PG8_SB(0, 1), cB + hstep, voffB); PG8_STAGE(PG8_SA(0, 1), cA + hstep, voffA);
    if (wr == 1) PG8_BAR;
    PG8_WAIT_V(4); PG8_BAR;
    PG8_STAGE(PG8_SB(1, 0), cB + kstep, voffB); PG8_STAGE(PG8_SA(1, 0), cA + kstep, voffA); PG8_STAGE(PG8_SB(1, 1), cB + hstep + kstep, voffB);
    PG8_WAIT_V(6); PG8_BAR;
    PG8_STAMP();
    for (;;) {
        const bool has_next = S.next(ui + 1, nxt);
        const char* nA = has_next ? (const char*)g.A + a_off(g, nxt.pm) : cA; const char* nB = has_next ? (const char*)g.Bt + (size_t)nxt.pn * tstep : cB;
        for (int t = 0; t < nt; t += 2) {
            const bool last = (t == nt - 2);
            const char* a1 = cA + (size_t)(t + 1) * kstep;
            const char* a2 = last ? nA : cA + (size_t)(t + 2) * kstep; const char* b2 = last ? nB : cB + (size_t)(t + 2) * kstep;
            const char* a3 = a2 + kstep; const char* b3 = b2 + kstep;
            if (last && has_next) S.a_ready(nxt);
            PG8_LDB(B0, 0, 0); PG8_SCHED; PG8_LDA(At, 0, 0); PG8_STAGE(PG8_SA(1, 1), a1 + hstep, voffA);
            PG8_WAIT_L(8); PG8_BAR; PG8_WAIT_L(0); PG8_MMA(0, 0, At, B0); PG8_BAR; PG8_SCHED;
            PG8_LDB(B1, 0, 1); PG8_STAGE(PG8_SB(0, 0), b2, voffB);
            PG8_BAR; PG8_WAIT_L(0); PG8_MMA(0, 1, At, B1); PG8_BAR;
            PG8_LDA(At, 0, 1); PG8_STAGE(PG8_SA(0, 0), a2, voffA);
            PG8_BAR; PG8_WAIT_L(0); PG8_MMA(1, 0, At, B0); PG8_BAR; PG8_SCHED;
            PG8_STAGE(PG8_SB(0, 1), b2 + hstep, voffB);
            PG8_WAIT_V(6); PG8_BAR; PG8_MMA(1, 1, At, B1); PG8_BAR;
            PG8_LDB(B0, 1, 0); PG8_SCHED; PG8_LDA(At, 1, 0); PG8_STAGE(PG8_SA(0, 1), a2 + hstep, voffA);
            PG8_WAIT_L(8); PG8_BAR; PG8_WAIT_L(0); PG8_MMA(0, 0, At, B0); PG8_BAR; PG8_SCHED;
            PG8_LDB(B1, 1, 1); PG8_STAGE(PG8_SB(1, 0), b3, voffB);
            PG8_BAR; PG8_WAIT_L(0); PG8_MMA(0, 1, At, B1); PG8_BAR;
            PG8_LDA(At, 1, 1); PG8_STAGE(PG8_SA(1, 0), a3, voffA);
            PG8_BAR; PG8_WAIT_L(0); PG8_MMA(1, 0, At, B0); PG8_BAR; PG8_SCHED;
            PG8_STAGE(PG8_SB(1, 1), b3 + hstep, voffB);
            PG8_WAIT_V(6); PG8_BAR; PG8_MMA(1, 1, At, B1); PG8_BAR;
        }
        PG8_STAMP();
        if constexpr (!Epi::AFTER_DRAIN) { E(acc, cur, wr, wc, fr, fq); S.done(cur); }
        PG8_STAMP();
        if (!has_next) break;
#pragma unroll
        for (int a = 0; a < 2; ++a)
#pragma unroll
            for (int b = 0; b < 2; ++b)
#pragma unroll
                for (int m = 0; m < 4; ++m)
#pragma unroll
                    for (int n = 0; n < 2; ++n) acc[a][b][m][n] = (f32x4){0.f, 0.f, 0.f, 0.f};
        cur = nxt; cA = nA; cB = nB; ++ui;
    }
    PG8_WAIT_V(0);
    if (wr == 0) PG8_BAR;
    PG8_BAR;
    if constexpr (Epi::AFTER_DRAIN) { E.fused(acc, cur, wr, wc, fr, fq, lds, wid, lane); S.done(cur); }
    PG8_STAMP();
    if (STAMP && wid == 0) { stamps[lane] = lane < nts ? (((unsigned long long)(unsigned)ts_hi << 32) | (unsigned)ts_lo) : 0ull;
        if (lane == 62) stamps[62] = rt_entry; if (lane == 63) stamps[63] = (unsigned long long)wall_clock64(); }
#undef PG8_STAMP
#undef PG8_SA
#undef PG8_SB
#undef PG8_STAGE
#undef PG8_LDA
#undef PG8_LDB
#undef PG8_MMA
#undef PG8_WAIT_V
#undef PG8_WAIT_L
#undef PG8_BAR
#undef PG8_SCHED
}
}
#define LAS __attribute__((address_space(3)))
typedef unsigned short bf16_t;
using pg8::bf16x8; using pg8::f32x4; using pg8::u32x4;
typedef unsigned u32x2 __attribute__((ext_vector_type(2)));
#define MFMA16(a, b, c) __builtin_amdgcn_mfma_f32_16x16x32_bf16(a, b, c, 0, 0, 0)
#define LDS_WAIT() asm volatile("s_waitcnt lgkmcnt(0)" ::: "memory")

constexpr int T = 16384, S = 8192, D = 2048, NINP = 4096, PLD = 4160, NIN = 3864, DFF = 5632;
constexpr int C_LRUY = 1024, C_Q = 2048, C_KC = 2560, C_VC = 2688, C_KS = 2816, C_VS = 2944, C_KW = 3072, C_VW = 3200, C_GATE = 3328, C_MQ = 3352;
constexpr size_t MiB = (size_t)1 << 20, KiB = 1024;
constexpr size_t WS_WIN = 2 * MiB, WS_WOUT = 18 * MiB, WS_WUP = 26 * MiB, WS_WDOWN = 70 * MiB, WS_WMEM = 92 * MiB, WS_MEMB = 96 * MiB;
constexpr size_t WS_WAT = 98 * MiB, WS_WXT = WS_WAT + 256 * KiB, WS_W1K = WS_WAT + 512 * KiB, WS_W1V = WS_WAT + 768 * KiB, WS_W2K = WS_WAT + 1024 * KiB, WS_W2V = WS_WAT + 1032 * KiB;
constexpr size_t WS_MK = 100 * MiB, WS_MVT = WS_MK + 512 * KiB, WS_KCMP = 101 * MiB, WS_VCMPT = WS_KCMP + 256 * KiB, WS_AGG = 102 * MiB;
constexpr size_t WS_VST = 104 * MiB, WS_VWT = 108 * MiB, WS_KSC = 112 * MiB, WS_KWC = 116 * MiB, WS_H0F = 120 * MiB, WS_H0B = 248 * MiB, WS_P = 312 * MiB, WS_CAT = 442 * MiB, WS_END = 510 * MiB;
constexpr size_t WS_H1B = WS_H0B, WS_ACT = WS_P, WS_STAT0 = 1 * MiB, WS_STAT1 = 1 * MiB + 256 * KiB, WS_KS8 = 506 * MiB, WS_VS8 = 508 * MiB, WS_LA = 120 * MiB, WS_LU = 184 * MiB, WS_MIX = 120 * MiB, WS_FFN = 184 * MiB;
constexpr int LDS_BYTES = 147456, EX_OFF = 131072;
constexpr float ALPHA = 1.189207115002721f, LN_EPS = 1e-5f;

struct Args { const float* in[28]; float* out; unsigned char* ws; int ph_lo, ph_hi; };
struct Ctx {
    const float *x, *mem, *ln_in_g, *ln_in_b, *w_in, *lru_cw, *lru_cb, *lru_wa, *lru_ba, *lru_wx, *lru_bx, *lru_lam, *pe_k, *w1k, *w2k, *pe_v, *w1v, *w2v, *w_mem, *w_out, *ln1_g, *ln1_b, *w_up, *fcw, *fcb, *w_down, *ln2_g, *ln2_b;
    float* out; float2* AGG; float2* STAT0; float2* STAT1; unsigned char* Ks8; unsigned char* Vs8; float* LA; float* LU; bf16_t* MIX; bf16_t* FFN;
    bf16_t *WinT, *WoutT, *WupT, *WdownT, *WmemT, *MEMB, *WaT, *WxT, *W1kT, *W1vT, *W2kT, *W2vT, *MK, *MVT, *KCMP, *VCMPT, *VsT, *VwT, *KsC, *KwC, *H0B, *P, *CAT, *H1B, *ACT;
};

__device__ __forceinline__ float bf2f(unsigned short b) { return __uint_as_float((unsigned)b << 16); }
__device__ __forceinline__ unsigned pkbf(float lo, float hi) { return pg8::cvt_pk_bf16(lo, hi); }
__device__ __forceinline__ bf16_t f2bf1(float v) { return (bf16_t)(pkbf(v, 0.f) & 0xffffu); }
__device__ __forceinline__ bf16x8 ld8(const bf16_t* p) { return __builtin_bit_cast(bf16x8, *(const u32x4*)p); }
__device__ __forceinline__ bf16x8 pack8(const f32x4 a, const f32x4 b) { u32x4 w; w.x = pkbf(a[0], a[1]); w.y = pkbf(a[2], a[3]); w.z = pkbf(b[0], b[1]); w.w = pkbf(b[2], b[3]); return __builtin_bit_cast(bf16x8, w); }
__device__ __forceinline__ bf16x8 join8(const u32x2 a, const u32x2 b) { u32x4 w; w.x = a.x; w.y = a.y; w.z = b.x; w.w = b.y; return __builtin_bit_cast(bf16x8, w); }
__device__ __forceinline__ bf16x8 scale8(const bf16x8 v, float s) { const u32x4 w = __builtin_bit_cast(u32x4, v); u32x4 o;
    o.x = pkbf(__uint_as_float(w.x << 16) * s, __uint_as_float(w.x & 0xffff0000u) * s); o.y = pkbf(__uint_as_float(w.y << 16) * s, __uint_as_float(w.y & 0xffff0000u) * s);
    o.z = pkbf(__uint_as_float(w.z << 16) * s, __uint_as_float(w.z & 0xffff0000u) * s); o.w = pkbf(__uint_as_float(w.w << 16) * s, __uint_as_float(w.w & 0xffff0000u) * s); return __builtin_bit_cast(bf16x8, o); }
__device__ __forceinline__ float wave_sum(float v) {
#pragma unroll
    for (int o = 1; o < 64; o <<= 1) v += __shfl_xor(v, o);
    return v; }
__device__ __forceinline__ float sigmoidf_(float x) { return __builtin_amdgcn_rcpf(1.0f + __expf(-x)); }
__device__ __forceinline__ float rdlane(float v, int l) { return __builtin_bit_cast(float, __builtin_amdgcn_readlane(__builtin_bit_cast(int, v), l)); }
using pg8::gelu_tanh;
#define MFMA8(a, b, c) __builtin_amdgcn_mfma_f32_16x16x32_fp8_fp8(a, b, c, 0, 0, 0)
__device__ __forceinline__ unsigned pk4fp8(float f0, float f1, float f2, float f3) { int w = __builtin_amdgcn_cvt_pk_fp8_f32(f0, f1, 0, false); w = __builtin_amdgcn_cvt_pk_fp8_f32(f2, f3, w, true); return (unsigned)w; }
__device__ __forceinline__ long mk64(unsigned lo, unsigned hi) { return (long)(((unsigned long long)hi << 32) | (unsigned long long)lo); }

#define XB_TMO      128
#define XB_XCNT(j)  (256  + 64 * (j))
#define XB_XSUB(j)  (1280 + 64 * (j))
#define XB_XGEN(j)  (2304 + 64 * (j))
#define XB_TOP      3328
#define XB_TOPGEN   3392
#define XCD_BAR_WORDS 3456
#define XB_SPIN_CAP (1u << 18)

__device__ __forceinline__ unsigned xb_ld(unsigned* p)              { return __hip_atomic_load(p, __ATOMIC_RELAXED, __HIP_MEMORY_SCOPE_AGENT); }
__device__ __forceinline__ unsigned xb_add(unsigned* p, unsigned v) { return __hip_atomic_fetch_add(p, v, __ATOMIC_RELAXED, __HIP_MEMORY_SCOPE_AGENT); }
__device__ __forceinline__ unsigned xb_xcc_id() { return (unsigned)__builtin_amdgcn_s_getreg((3 << 11) | 20) & 0xFu; }
#define XB_SPIN(cond, bar) do { unsigned _sp = 0; while (cond) { __builtin_amdgcn_s_sleep(1); \
    if ((++_sp & 255u) == 0u) { if (xb_ld(&(bar)[XB_TMO])) break; if (_sp > XB_SPIN_CAP) { atomicAdd(&(bar)[XB_TMO], 1u); break; } } } } while (0)

struct XcdBarrier {
    unsigned* bar; unsigned x;
    volatile LAS unsigned* st;
};

__device__ __forceinline__ XcdBarrier xcd_barrier_post(unsigned* bar, volatile LAS unsigned* st) {
    XcdBarrier b; b.bar = bar; b.x = xb_xcc_id(); b.st = st;
    if (threadIdx.x == 0) (void)xb_add(&bar[XB_XCNT(b.x)], 1u);
    return b;
}
__device__ __forceinline__ void xcd_barrier_complete(unsigned* bar, unsigned x, unsigned& nloc, unsigned& nx) {
    const unsigned G = gridDim.x * gridDim.y * gridDim.z;
    unsigned sum, cnt, mine, sp = 0u;
    for (;;) {
        sum = 0u; cnt = 0u; mine = 0u;
#pragma unroll
        for (unsigned j = 0; j < 16; ++j) { const unsigned c = xb_ld(&bar[XB_XCNT(j)]); sum += c; cnt += (c > 0u) ? 1u : 0u; mine = (j == x) ? c : mine; }
        if (sum == G) break;
        __builtin_amdgcn_s_sleep(1);
        if ((++sp & 255u) == 0u) { if (xb_ld(&bar[XB_TMO])) break; if (sp > XB_SPIN_CAP) { atomicAdd(&bar[XB_TMO], 1u); break; } }
    }
    nloc = mine > 0u ? mine : 1u; nx = cnt > 0u ? cnt : 1u;
}

__device__ __forceinline__ void xcd_barrier(const XcdBarrier& b) {
    asm volatile("s_waitcnt vmcnt(0)" ::: "memory");
    __syncthreads();
    if (threadIdx.x == 0) {
        unsigned* bar = b.bar;
        __builtin_amdgcn_s_waitcnt(0);
        unsigned nloc = b.st[0], nx = b.st[1];
        if (nloc == 0u) { xcd_barrier_complete(bar, b.x, nloc, nx); b.st[0] = nloc; b.st[1] = nx; }
        const unsigned old = xb_add(&bar[XB_XSUB(b.x)], 1u);
        const unsigned gen = old / nloc;
        if (old + 1u == (gen + 1u) * nloc) {
            __builtin_amdgcn_fence(__ATOMIC_RELEASE, "agent");
            asm volatile("s_waitcnt vmcnt(0)" ::: "memory");
            const unsigned og = xb_add(&bar[XB_TOP], 1u);
            const unsigned tg = og / nx;
            if (og + 1u == (tg + 1u) * nx) xb_add(&bar[XB_TOPGEN], 1u);
            else XB_SPIN(xb_ld(&bar[XB_TOPGEN]) == tg, bar);
            __builtin_amdgcn_fence(__ATOMIC_ACQUIRE, "agent");
            xb_add(&bar[XB_XGEN(b.x)], 1u);
            asm volatile("s_waitcnt vmcnt(0)" ::: "memory");
        } else {
            XB_SPIN(xb_ld(&bar[XB_XGEN(b.x)]) == gen, bar);
            __builtin_amdgcn_fence(__ATOMIC_ACQUIRE, "agent");
            asm volatile("s_waitcnt vmcnt(0)" ::: "memory");
        }
    }
    __syncthreads();
}

template <int MODE>
__device__ __forceinline__ void transpose_item(const float* W, int K, int N, bf16_t* WT, LAS float* scr, int item, int nblk, int lane, int ldw = 0) {
    if (ldw == 0) ldw = K;
    const int kb = item / nblk, nb = item % nblk, k0 = 64 * kb, n0 = 64 * nb, nn = n0 + lane;
#pragma unroll 1
    for (int h = 0; h < 2; ++h) { float tv[32];
#pragma unroll
        for (int i = 0; i < 32; ++i) tv[i] = (nn < N) ? W[(size_t)(k0 + 32 * h + i) * N + nn] : 0.f;
#pragma unroll
        for (int i = 0; i < 32; ++i) scr[(32 * h + i) * 65 + lane] = tv[i]; }
    LDS_WAIT();
    const int c = lane & 7;
#pragma unroll
    for (int j = 0; j < 8; ++j) { const int n = (lane >> 3) + 8 * j; const LAS float* s = scr + (8 * c) * 65 + n;
        u32x4 o; o.x = pkbf(s[0], s[65]); o.y = pkbf(s[130], s[195]); o.z = pkbf(s[260], s[325]); o.w = pkbf(s[390], s[455]);
        int row = n0 + n;
        if (MODE == 1) { const int bj = row / 5632, rem = row % 5632; row = 256 * (rem / 128) + 128 * bj + (rem % 128); }
        if (MODE == 2) { const int kk8 = k0 + 8 * c; *(u32x4*)(WT + ((size_t)(row >> 4) * (K >> 5) + (kk8 >> 5)) * 512 + ((((kk8 & 31) >> 3) * 16 + (row & 15)) * 8)) = o; }
        else *(u32x4*)(WT + (size_t)row * ldw + k0 + 8 * c) = o; }
    LDS_WAIT();
}
template <int NR>
__device__ __forceinline__ void ln_rows(const float* xbase, const float* g, const float* bt, float* ofbase, bf16_t* obbase, float2* st, int m0, int mstride, int lane) {
    f32x4 v[NR][8]; float s[NR], s2[NR], mean[NR], rstd[NR];
#pragma unroll
    for (int i = 0; i < NR; ++i) { const int m = (m0 + i * mstride < T) ? m0 + i * mstride : T - 1; s[i] = 0.f;
#pragma unroll
        for (int j = 0; j < 8; ++j) v[i][j] = ((const f32x4*)(xbase + (size_t)m * D))[lane + 64 * j]; }
#pragma unroll
    for (int i = 0; i < NR; ++i)
#pragma unroll
        for (int j = 0; j < 8; ++j) s[i] += (v[i][j][0] + v[i][j][1]) + (v[i][j][2] + v[i][j][3]);
#pragma unroll
    for (int o = 1; o < 64; o <<= 1)
#pragma unroll
        for (int i = 0; i < NR; ++i) s[i] += __shfl_xor(s[i], o);
#pragma unroll
    for (int i = 0; i < NR; ++i) { mean[i] = s[i] * (1.f / 2048.f); s2[i] = 0.f;
#pragma unroll
        for (int j = 0; j < 8; ++j) { v[i][j] = v[i][j] - mean[i]; s2[i] += (v[i][j][0] * v[i][j][0] + v[i][j][1] * v[i][j][1]) + (v[i][j][2] * v[i][j][2] + v[i][j][3] * v[i][j][3]); } }
#pragma unroll
    for (int o = 1; o < 64; o <<= 1)
#pragma unroll
        for (int i = 0; i < NR; ++i) s2[i] += __shfl_xor(s2[i], o);
#pragma unroll
    for (int i = 0; i < NR; ++i) rstd[i] = 1.0f / sqrtf(s2[i] * (1.f / 2048.f) + LN_EPS);
#pragma unroll
    for (int j = 0; j < 8; ++j) { const f32x4 gg = ((const f32x4*)g)[lane + 64 * j], bb = ((const f32x4*)bt)[lane + 64 * j];
#pragma unroll
        for (int i = 0; i < NR; ++i) { const int m = m0 + i * mstride; if (m < T) { const f32x4 y = v[i][j] * rstd[i] * gg + bb;
            if (ofbase) ((f32x4*)(ofbase + (size_t)m * D))[lane + 64 * j] = y;
            if (obbase) { u32x2 w; w.x = pkbf(y[0], y[1]); w.y = pkbf(y[2], y[3]); ((u32x2*)(obbase + (size_t)m * D))[lane + 64 * j] = w; } } } }
    if (st && lane == 0) {
#pragma unroll
        for (int i = 0; i < NR; ++i) { const int m = m0 + i * mstride; if (m < T) st[m] = make_float2(mean[i], rstd[i]); } }
}
template <int NR>
__device__ __forceinline__ void ln_fuse_rows(const float* xbase, const float2* sta, const float* ga, const float* ba, const bf16_t* addbase, float* ybase, const float* gb, const float* bb,
                                             float* ofbase, bf16_t* obbase, float2* stb, int m0, int mstride, int lane) {
    f32x4 v[NR][8]; float s[NR], s2[NR], mean[NR], rstd[NR];
#pragma unroll
    for (int i = 0; i < NR; ++i) { const int m = (m0 + i * mstride < T) ? m0 + i * mstride : T - 1; const float2 st = sta[m]; s[i] = 0.f;
#pragma unroll
        for (int j = 0; j < 8; ++j) { const f32x4 x = ((const f32x4*)(xbase + (size_t)m * D))[lane + 64 * j]; const u32x2 aw = ((const u32x2*)(addbase + (size_t)m * D))[lane + 64 * j];
            const f32x4 g4 = ((const f32x4*)ga)[lane + 64 * j], b4 = ((const f32x4*)ba)[lane + 64 * j];
            const f32x4 ad = (f32x4){__uint_as_float(aw.x << 16), __uint_as_float(aw.x & 0xffff0000u), __uint_as_float(aw.y << 16), __uint_as_float(aw.y & 0xffff0000u)};
            v[i][j] = (((x - st.x) * st.y) * g4 + b4) * ALPHA + ad; } }
    if (ybase) {
#pragma unroll
        for (int i = 0; i < NR; ++i) { const int m = m0 + i * mstride; if (m < T) {
#pragma unroll
            for (int j = 0; j < 8; ++j) ((f32x4*)(ybase + (size_t)m * D))[lane + 64 * j] = v[i][j]; } } }
#pragma unroll
    for (int i = 0; i < NR; ++i)
#pragma unroll
        for (int j = 0; j < 8; ++j) s[i] += (v[i][j][0] + v[i][j][1]) + (v[i][j][2] + v[i][j][3]);
#pragma unroll
    for (int o = 1; o < 64; o <<= 1)
#pragma unroll
        for (int i = 0; i < NR; ++i) s[i] += __shfl_xor(s[i], o);
#pragma unroll
    for (int i = 0; i < NR; ++i) { mean[i] = s[i] * (1.f / 2048.f); s2[i] = 0.f;
#pragma unroll
        for (int j = 0; j < 8; ++j) { v[i][j] = v[i][j] - mean[i]; s2[i] += (v[i][j][0] * v[i][j][0] + v[i][j][1] * v[i][j][1]) + (v[i][j][2] * v[i][j][2] + v[i][j][3] * v[i][j][3]); } }
#pragma unroll
    for (int o = 1; o < 64; o <<= 1)
#pragma unroll
        for (int i = 0; i < NR; ++i) s2[i] += __shfl_xor(s2[i], o);
#pragma unroll
    for (int i = 0; i < NR; ++i) rstd[i] = 1.0f / sqrtf(s2[i] * (1.f / 2048.f) + LN_EPS);
#pragma unroll
    for (int j = 0; j < 8; ++j) { const f32x4 gg = ((const f32x4*)gb)[lane + 64 * j], bq = ((const f32x4*)bb)[lane + 64 * j];
#pragma unroll
        for (int i = 0; i < NR; ++i) { const int m = m0 + i * mstride; if (m < T) { const f32x4 y = v[i][j] * rstd[i] * gg + bq;
            if (ofbase) ((f32x4*)(ofbase + (size_t)m * D))[lane + 64 * j] = y;
            if (obbase) { u32x2 w; w.x = pkbf(y[0], y[1]); w.y = pkbf(y[2], y[3]); ((u32x2*)(obbase + (size_t)m * D))[lane + 64 * j] = w; } } } }
    if (stb && lane == 0) {
#pragma unroll
        for (int i = 0; i < NR; ++i) { const int m = m0 + i * mstride; if (m < T) stb[m] = make_float2(mean[i], rstd[i]); } }
}
__device__ __forceinline__ void phase0(const Ctx& c, LAS unsigned char* lds, int gw, int NGW, int wave, int lane) {
    LAS float* scr = (LAS float*)(lds + wave * 16640);
    constexpr int I0 = 32 * 64, I1 = 32 * 32, I2 = 32 * 176, I4 = 32 * 16, I5 = 32, I6 = 32, I7 = 32, I8 = 32, I9 = 1, I10 = 1;
    constexpr int NIT = I0 + I1 + I2 + I4 + I5 + I6 + I7 + I8 + I9 + I10;
    for (int it = gw; it < NIT; it += NGW) {
        int r = it;
        if (r < I0) { transpose_item<0>(c.w_in, 2048, NIN, c.WinT, scr, r, 64, lane); continue; } r -= I0;
        if (r < I1) { transpose_item<0>(c.w_out, 2048, 2048, c.WoutT, scr, r, 32, lane); continue; } r -= I1;
        if (r < I2) { transpose_item<1>(c.w_up, 2048, 11264, c.WupT, scr, r, 176, lane); continue; } r -= I2;
        if (r < I4) { transpose_item<2>(c.w_mem, 2048, 1024, c.WmemT, scr, r, 16, lane); continue; } r -= I4;
        if (r < I5) { transpose_item<2>(c.lru_wa + (r >> 2) * 16384, 128, 128, c.WaT + (r >> 2) * 16384, scr, r & 3, 2, lane); continue; } r -= I5;
        if (r < I6) { transpose_item<2>(c.lru_wx + (r >> 2) * 16384, 128, 128, c.WxT + (r >> 2) * 16384, scr, r & 3, 2, lane); continue; } r -= I6;
        if (r < I7) { transpose_item<2>(c.w1k, 2048, 64, c.W1kT, scr, r, 1, lane); continue; } r -= I7;
        if (r < I8) { transpose_item<2>(c.w1v, 2048, 64, c.W1vT, scr, r, 1, lane); continue; } r -= I8;
        if (r < I9) { transpose_item<0>(c.w2k, 64, 64, c.W2kT, scr, r, 1, lane); continue; } r -= I9;
        transpose_item<0>(c.w2v, 64, 64, c.W2vT, scr, r, 1, lane);
    }
    for (int m = gw; m < T; m += 2 * NGW) ln_rows<2>(c.x, c.ln_in_g, c.ln_in_b, nullptr, c.H0B, c.STAT0, m, NGW, lane);
    for (int i = gw * 64 + lane; i < 512 * 2048 / 4; i += NGW * 64) { const f32x4 v = ((const f32x4*)c.mem)[i]; u32x2 w; w.x = pkbf(v[0], v[1]); w.y = pkbf(v[2], v[3]); const int m = i >> 9, k = (i & 511) * 4;
        *(u32x2*)(c.MEMB + ((size_t)(m >> 4) * 64 + (k >> 5)) * 512 + ((((k & 31) >> 3) * 16 + (m & 15)) * 8) + (k & 7)) = w; }
}
__device__ __forceinline__ void lru_walk1(const Ctx& c, LAS unsigned char* lds, int tp0, int tid) {
    asm volatile("" : "+v"(tid));
    const int ck0 = tp0 & 127, n = (tp0 >> 7) & 7, b = tp0 >> 10, lane = tid & 63, w = tid >> 6;
    LAS float* XC = (LAS float*)lds; LAS bf16_t* XB = (LAS bf16_t*)(lds + 32768);
    const int ch = tid & 127, sg = tid >> 7, chg = n * 128 + ch;
    const float w0 = c.lru_cw[chg], w1 = c.lru_cw[1024 + chg], w2 = c.lru_cw[2048 + chg], w3 = c.lru_cw[3072 + chg], cb = c.lru_cb[chg];
    const bf16_t* xp = c.P + (size_t)b * S * PLD + chg;
    const int r = lane & 15, q = lane >> 4, chl = 16 * w + r, cg2 = n * 128 + chl;
    const float bav = c.lru_ba[cg2], bxv = c.lru_bx[cg2], sp = log1pf(expf(-c.lru_lam[cg2]));
    float xr[19];
#define LRU_LOAD(CK) do { const int tt0_ = (CK) * 64 + sg * 16 - 3; _Pragma("unroll") for (int i = 0; i < 19; ++i) xr[i] = (tt0_ + i >= 0) ? bf2f(xp[(size_t)(tt0_ + i) * PLD]) : 0.f; } while (0)
    LRU_LOAD(ck0);
#pragma unroll 1
    for (int it = 0; it < 8; ++it) { const int ck = ck0 + it; const size_t row0 = (size_t)b * S + ck * 64;
        bf16x8 wa[4], wx[4];
#pragma unroll
        for (int ks = 0; ks < 4; ++ks) { const size_t wo = (size_t)n * 16384 + (size_t)((w * 4 + ks) * 64 + lane) * 8; wa[ks] = ld8(c.WaT + wo); wx[ks] = ld8(c.WxT + wo); }
        { const int tl0 = sg * 16;
#pragma unroll
          for (int i = 0; i < 16; ++i) { const float xc = cb + w0 * xr[i] + w1 * xr[i + 1] + w2 * xr[i + 2] + w3 * xr[i + 3]; XC[(tl0 + i) * 128 + ch] = xc; XB[(tl0 + i) * 136 + ch] = f2bf1(xc); } }
        if (it < 7) LRU_LOAD(ck + 1);
        __syncthreads();
        f32x4 ga[4], gx[4];
#pragma unroll
        for (int i = 0; i < 4; ++i) { ga[i] = (f32x4){0.f, 0.f, 0.f, 0.f}; gx[i] = ga[i]; }
#pragma unroll
        for (int ks = 0; ks < 4; ++ks)
#pragma unroll
            for (int rt = 0; rt < 4; ++rt) { const bf16x8 a = *(const LAS bf16x8*)(XB + (16 * rt + r) * 136 + 32 * ks + 8 * q); ga[rt] = MFMA16(a, wa[ks], ga[rt]); gx[rt] = MFMA16(a, wx[ks], gx[rt]); }
        float At = 1.f, Ht = 0.f;
#pragma unroll
        for (int rt = 0; rt < 4; ++rt) { float Al = 1.f, Hl = 0.f;
#pragma unroll
            for (int j = 0; j < 4; ++j) { const int t = 16 * rt + 4 * q + j; const float da = 1.0f + __expf(fminf(-(ga[rt][j] + bav), 80.0f)), dx = 1.0f + __expf(fminf(-(gx[rt][j] + bxv), 80.0f)), rc = __builtin_amdgcn_rcpf(da * dx);
                const float rr = rc * dx, ii = rc * da, la = -8.0f * rr * sp, x2 = 2.0f * la;
                float em = -x2 * (1.0f + x2 * (0.5f + x2 * (0.16666667f + x2 * (0.041666668f + x2 * 0.0083333338f))));
                if (__ballot(x2 <= -0.25f) != 0ull) em = (x2 > -0.25f) ? em : 1.0f - __expf(x2);
                const float av = __expf(la), uv = __builtin_amdgcn_sqrtf(em) * ii * XC[t * 128 + chl];
                c.LA[(row0 + t) * 1024 + cg2] = av; c.LU[(row0 + t) * 1024 + cg2] = uv; Hl = av * Hl + uv; Al *= av; }
            { const float Ap = __shfl_xor(Al, 16), Hp = __shfl_xor(Hl, 16); if (q & 1) { Hl = Hp * Al + Hl; Al = Ap * Al; } }
            { const float Ap = __shfl_xor(Al, 32), Hp = __shfl_xor(Hl, 32); if (q & 2) { Hl = Hp * Al + Hl; Al = Ap * Al; } }
            Ht = Ht * Al + Hl; At *= Al; }
        if (q == 3) c.AGG[((size_t)b * 128 + ck) * 1024 + cg2] = make_float2(At, Ht);
        __syncthreads();
    }
#undef LRU_LOAD
}
__device__ __forceinline__ void lru_walk2(const Ctx& c, LAS unsigned char* lds, int tp0, int tid) {
    asm volatile("" : "+v"(tid));
    const int ck0 = tp0 & 127, n = (tp0 >> 7) & 7, b = tp0 >> 10, ch = tid & 127, sg = tid >> 7, chg = n * 128 + ch;
    LAS float* SEG = (LAS float*)(lds + 116736); LAS float* SEG2 = (LAS float*)(lds + 120832); LAS float* CAR = (LAS float*)(lds + 124928);
    float av[16], uv[16], yv[16];
#define LRU2_LOAD(CK) do { const size_t r0_ = (size_t)b * S + (CK) * 64 + sg * 16; _Pragma("unroll") for (int i = 0; i < 16; ++i) { av[i] = c.LA[(r0_ + i) * 1024 + chg]; uv[i] = c.LU[(r0_ + i) * 1024 + chg]; \
            yv[i] = bf2f(c.P[(r0_ + i) * PLD + C_LRUY + chg]); } } while (0)
    LRU2_LOAD(ck0);
#pragma unroll 1
    for (int it = 0; it < 8; ++it) { const int ck = ck0 + it; const size_t row0 = (size_t)b * S + ck * 64 + sg * 16;
        float A = 1.f, H = 0.f;
#pragma unroll
        for (int i = 0; i < 16; ++i) { H = av[i] * H + uv[i]; A *= av[i]; }
        SEG[(sg * 128 + ch) * 2] = A; SEG[(sg * 128 + ch) * 2 + 1] = H;
        if (it == 0) { float CA = 1.f, CH = 0.f; const int per = (ck + 3) >> 2, lo = sg * per, hi = (lo + per < ck) ? lo + per : ck;
#pragma unroll 8
            for (int cc = lo; cc < hi; ++cc) { const float2 v = c.AGG[((size_t)b * 128 + cc) * 1024 + chg]; CH = v.x * CH + v.y; CA *= v.x; }
            SEG2[(sg * 128 + ch) * 2] = CA; SEG2[(sg * 128 + ch) * 2 + 1] = CH; }
        __syncthreads();
        float Hc = 0.f;
        if (it == 0) {
#pragma unroll
            for (int s = 0; s < 4; ++s) Hc = SEG2[(s * 128 + ch) * 2] * Hc + SEG2[(s * 128 + ch) * 2 + 1]; }
        else Hc = CAR[ch];
        for (int s = 0; s < sg; ++s) Hc = SEG[(s * 128 + ch) * 2] * Hc + SEG[(s * 128 + ch) * 2 + 1];
        float ov[16];
#pragma unroll
        for (int i = 0; i < 16; ++i) { Hc = av[i] * Hc + uv[i]; ov[i] = gelu_tanh(yv[i]) * Hc; }
        if (it < 7) LRU2_LOAD(ck + 1);
#pragma unroll
        for (int i = 0; i < 16; ++i) c.CAT[(row0 + i) * D + chg] = f2bf1(ov[i]);
        __syncthreads();
        if (sg == 3) CAR[ch] = Hc;
    }
    __syncthreads();
#undef LRU2_LOAD
}
__device__ __forceinline__ void vt_tile(const Ctx& c, LAS unsigned char* lds, int bt, int tid) {
    LAS bf16_t* TL = (LAS bf16_t*)lds;
    const size_t tok0 = (size_t)bt * 64; const int b = bt >> 7, blk = bt & 127;
#pragma unroll
    for (int i = 0; i < 8; ++i) { const int cidx = tid + 512 * i, row = cidx >> 6, chn = cidx & 63; *(LAS u32x4*)(TL + row * 520 + chn * 8) = *(const u32x4*)(c.P + (tok0 + row) * PLD + C_KS + chn * 8); }
    __syncthreads();
#pragma unroll
    for (int i = 2; i < 4; ++i) { const int cid = tid + 512 * i, ln = cid & 63, f = (cid >> 6) & 7, gg = (cid >> 9) & 1, arr = cid >> 10, r = ln & 15, q = ln >> 4;
        const size_t blkoff = ((size_t)(b * 2 + gg) * 128 + blk) * 4096 + (size_t)(f * 64 + ln) * 8;
        { const int k4 = f >> 1, ks2 = f & 1; *(u32x4*)((arr ? c.KwC : c.KsC) + blkoff) = *(const LAS u32x4*)(TL + (16 * k4 + r) * 520 + arr * 256 + 64 * gg + 32 * ks2 + 8 * q); }
        { const int kp2 = f >> 2, dt = f & 3, col = 128 + arr * 256 + 64 * gg + 16 * dt + r; unsigned v[8];
#pragma unroll
          for (int e = 0; e < 8; ++e) v[e] = TL[(32 * kp2 + 16 * (e >> 2) + 4 * q + (e & 3)) * 520 + col];
          u32x4 o; o.x = v[0] | (v[1] << 16); o.y = v[2] | (v[3] << 16); o.z = v[4] | (v[5] << 16); o.w = v[6] | (v[7] << 16); *(u32x4*)((arr ? c.VwT : c.VsT) + blkoff) = o; } }
    { const int ln = tid & 63, r = ln & 15, q = ln >> 4, f2 = (tid >> 6) & 3, gg = tid >> 8; const size_t bo = ((size_t)(b * 2 + gg) * 128 + blk) * 4096 + (size_t)(f2 * 64 + ln) * 16;
      { const LAS bf16_t* src = TL + (16 * f2 + r) * 520 + 64 * gg + 8 * q; u32x4 o;
        o.x = pk4fp8(bf2f(src[0]), bf2f(src[1]), bf2f(src[2]), bf2f(src[3])); o.y = pk4fp8(bf2f(src[4]), bf2f(src[5]), bf2f(src[6]), bf2f(src[7]));
        o.z = pk4fp8(bf2f(src[32]), bf2f(src[33]), bf2f(src[34]), bf2f(src[35])); o.w = pk4fp8(bf2f(src[36]), bf2f(src[37]), bf2f(src[38]), bf2f(src[39])); *(u32x4*)(c.Ks8 + bo) = o; }
      { const int kp2 = f2 >> 1, dtp = f2 & 1; unsigned wv[4];
#pragma unroll
        for (int hf = 0; hf < 2; ++hf) { const int col = 128 + 64 * gg + 16 * (2 * dtp + hf) + r; const LAS bf16_t* s0 = TL + (32 * kp2 + 4 * q) * 520 + col; const LAS bf16_t* s1 = s0 + 16 * 520;
            wv[2 * hf] = pk4fp8(bf2f(s0[0]), bf2f(s0[520]), bf2f(s0[1040]), bf2f(s0[1560])); wv[2 * hf + 1] = pk4fp8(bf2f(s1[0]), bf2f(s1[520]), bf2f(s1[1040]), bf2f(s1[1560])); }
        u32x4 o; o.x = wv[0]; o.y = wv[1]; o.z = wv[2]; o.w = wv[3]; *(u32x4*)(c.Vs8 + bo) = o; } }
    __syncthreads();
}
__device__ __forceinline__ void compress_task(const Ctx& c, LAS unsigned char* lds, int task, int tid) {
    const int lane = tid & 63, w = tid >> 6;
    const int nb = task & 31, g = (task >> 5) & 1, b = (task >> 6) & 1, kv = task >> 7, r = lane & 15, q = lane >> 4;
    LAS float* PART = (LAS float*)lds; LAS bf16_t* hid = (LAS bf16_t*)(lds + 32768);
    int n = 16 * nb + r; if (n > 510) n = 510;
    const bf16_t* W1T = kv ? c.W1vT : c.W1kT; const bf16_t* W2T = kv ? c.W2vT : c.W2kT; const float* pe = kv ? c.pe_v : c.pe_k;
    const bf16_t* arow = c.P + ((size_t)b * S + 16 * n) * PLD + (kv ? C_VC : C_KC) + 64 * g;
    f32x4 acc[4];
#pragma unroll
    for (int i = 0; i < 4; ++i) acc[i] = (f32x4){0.f, 0.f, 0.f, 0.f};
#pragma unroll
    for (int k8 = 0; k8 < 8; ++k8) { const int ks = 8 * w + k8, l = ks >> 1, d0 = (ks & 1) * 32 + 8 * q;
        const u32x4 raw = *(const u32x4*)(arow + (size_t)l * PLD + d0); const f32x4 p0 = *(const f32x4*)(pe + l * 64 + d0), p1 = *(const f32x4*)(pe + l * 64 + d0 + 4);
        u32x4 o; o.x = pkbf(__uint_as_float(raw.x << 16) + p0[0], __uint_as_float(raw.x & 0xffff0000u) + p0[1]); o.y = pkbf(__uint_as_float(raw.y << 16) + p0[2], __uint_as_float(raw.y & 0xffff0000u) + p0[3]);
        o.z = pkbf(__uint_as_float(raw.z << 16) + p1[0], __uint_as_float(raw.z & 0xffff0000u) + p1[1]); o.w = pkbf(__uint_as_float(raw.w << 16) + p1[2], __uint_as_float(raw.w & 0xffff0000u) + p1[3]);
        const bf16x8 a = __builtin_bit_cast(bf16x8, o);
#pragma unroll
        for (int et = 0; et < 4; ++et) acc[et] = MFMA16(a, ld8(W1T + (size_t)((et * 64 + ks) * 64 + lane) * 8), acc[et]); }
#pragma unroll
    for (int et = 0; et < 4; ++et)
#pragma unroll
        for (int j = 0; j < 4; ++j) PART[(w * 16 + 4 * q + j) * 64 + 16 * et + r] = acc[et][j];
    __syncthreads();
    if (w == 0) {
#pragma unroll
        for (int et = 0; et < 4; ++et)
#pragma unroll
            for (int j = 0; j < 4; ++j) { float s = 0.f;
#pragma unroll
                for (int ww = 0; ww < 8; ++ww) s += PART[(ww * 16 + 4 * q + j) * 64 + 16 * et + r];
                hid[(4 * q + j) * 72 + 16 * et + r] = f2bf1(gelu_tanh(s)); }
        LDS_WAIT();
        f32x4 o2[4];
#pragma unroll
        for (int i = 0; i < 4; ++i) o2[i] = (f32x4){0.f, 0.f, 0.f, 0.f};
#pragma unroll
        for (int ks = 0; ks < 2; ++ks) { const bf16x8 a = *(const LAS bf16x8*)(hid + r * 72 + 32 * ks + 8 * q);
#pragma unroll
            for (int ft = 0; ft < 4; ++ft) o2[ft] = MFMA16(a, ld8(W2T + (16 * ft + r) * 64 + 32 * ks + 8 * q), o2[ft]); }
#pragma unroll
        for (int ft = 0; ft < 4; ++ft)
#pragma unroll
            for (int j = 0; j < 4; ++j) { const int nn = 16 * nb + 4 * q + j; const float val = nn < 511 ? o2[ft][j] : 0.f;
                const int f = 16 * ft + r;
                if (!kv) c.KCMP[(size_t)(b * 2 + g) * 32768 + ((((nn >> 4) * 2 + (f >> 5)) * 64 + ((f & 31) >> 3) * 16 + (nn & 15)) * 8) + (f & 7)] = f2bf1(val);
                else c.VCMPT[(size_t)(b * 2 + g) * 32768 + ((((nn >> 5) * 4 + ft) * 64 + ((nn & 15) >> 2) * 16 + r) * 8) + (nn & 3) + 4 * ((nn >> 4) & 1)] = f2bf1(val); } }
    __syncthreads();
}
__device__ __forceinline__ void memkv_task(const Ctx& c, int task, int lane) {
    const int rt = task >> 6, ct = task & 63, r = lane & 15, q = lane >> 4; f32x4 acc = (f32x4){0.f, 0.f, 0.f, 0.f};
    const bf16_t* ap = c.MEMB + (size_t)rt * 32768 + lane * 8; const bf16_t* bp = c.WmemT + (size_t)ct * 32768 + lane * 8;
#pragma unroll 8
    for (int ks = 0; ks < 64; ++ks) acc = MFMA16(ld8(ap + 512 * ks), ld8(bp + 512 * ks), acc);
#pragma unroll
    for (int j = 0; j < 4; ++j) { const int row = 16 * rt + 4 * q + j;
        const int bb = row >> 8, key = row & 255, col = (16 * ct + r) & 511, h = col >> 7, dd = col & 127;
        if (ct < 32) c.MK[(size_t)(bb * 4 + h) * 32768 + ((((key >> 4) * 4 + (dd >> 5)) * 64 + ((dd & 31) >> 3) * 16 + (key & 15)) * 8) + (dd & 7)] = f2bf1(acc[j]);
        else c.MVT[(size_t)(bb * 4 + h) * 32768 + ((((key >> 5) * 8 + (dd >> 4)) * 64 + ((key & 15) >> 2) * 16 + (dd & 15)) * 8) + (key & 3) + 4 * ((key >> 4) & 1)] = f2bf1(acc[j]); }
}
__device__ __forceinline__ void nsa_item(const Ctx& c, LAS unsigned char* wl, LAS unsigned char* sl, int item, int lane) {
    const int qt = item & 511, g = (item >> 9) & 1, b = item >> 10, r = lane & 15, q = lane >> 4, t0 = 16 * qt, cur = qt >> 2;
    const size_t rowb = (size_t)b * S; const bf16_t* Pb = c.P + rowb * PLD;
    LAS float* impA = (LAS float*)wl; LAS float* impB = impA + 2048; LAS float* OACC = (LAS float*)wl; LAS float* GL = (LAS float*)(sl + 320);
    const f32x4 z4 = (f32x4){0.f, 0.f, 0.f, 0.f};
#pragma unroll
    for (int i = 0; i < 16; ++i) ((LAS f32x4*)wl)[lane + 64 * i] = z4;
#pragma unroll
    for (int i = 0; i < 3; ++i) { const int idx = lane + 64 * i, qi = idx / 12, k = idx - qi * 12; GL[idx] = sigmoidf_(bf2f(Pb[(size_t)(t0 + qi) * PLD + C_GATE + 12 * g + k])); }
    bf16x8 qf[4][2];
#define LOAD_QF() do { _Pragma("unroll") for (int h = 0; h < 4; ++h) _Pragma("unroll") for (int ks = 0; ks < 2; ++ks) qf[h][ks] = scale8(ld8(Pb + (size_t)(t0 + r) * PLD + C_Q + (4 * g + h) * 64 + 32 * ks + 8 * q), 0.125f); } while (0)
    LOAD_QF();
    const int nkt = (qt + 15) >> 4; const bf16_t* Kc = c.KCMP + (size_t)(b * 2 + g) * 32768 + lane * 8; const bf16_t* Vc = c.VCMPT + (size_t)(b * 2 + g) * 32768 + lane * 8;
    float m[4], l[4];
#pragma unroll
    for (int h = 0; h < 4; ++h) { m[h] = -1e30f; l[h] = 0.f; }
    for (int kt = 0; kt < nkt; ++kt) { const bf16x8 k0 = ld8(Kc + kt * 1024), k1 = ld8(Kc + kt * 1024 + 512);
#pragma unroll
        for (int h = 0; h < 4; ++h) { f32x4 s = MFMA16(k0, qf[h][0], z4); s = MFMA16(k1, qf[h][1], s);
            if (16 * kt + 15 >= qt - 1) {
#pragma unroll
                for (int j = 0; j < 4; ++j) { const int nk = 16 * kt + 4 * q + j; if (!((nk < qt - 1) || (nk == qt - 1 && r == 15))) s[j] = -1e30f; } }
            const float tm = fmaxf(fmaxf(s[0], s[1]), fmaxf(s[2], s[3])), mn = fmaxf(m[h], tm); float ls = l[h] * __expf(m[h] - mn);
#pragma unroll
            for (int j = 0; j < 4; ++j) ls += s[j] > -1e29f ? __expf(s[j] - mn) : 0.f;
            l[h] = ls; m[h] = mn; } }
    float rl[4];
#pragma unroll
    for (int h = 0; h < 4; ++h) {
#pragma unroll
        for (int o = 16; o < 64; o <<= 1) { const float mo = __shfl_xor(m[h], o), lo = __shfl_xor(l[h], o), mn = fmaxf(m[h], mo); l[h] = l[h] * __expf(m[h] - mn) + lo * __expf(mo - mn); m[h] = mn; }
        rl[h] = l[h] > 0.f ? 1.0f / l[h] : 0.f; }
    f32x4 oc[4][4];
#pragma unroll
    for (int h = 0; h < 4; ++h)
#pragma unroll
        for (int dt = 0; dt < 4; ++dt) oc[h][dt] = z4;
    for (int kp = 0; kp < (nkt + 1) / 2; ++kp) { f32x4 pp[4][2];
#pragma unroll
        for (int hf = 0; hf < 2; ++hf) { const int kt = 2 * kp + hf;
            if (kt < nkt) { const bf16x8 k0 = ld8(Kc + kt * 1024), k1 = ld8(Kc + kt * 1024 + 512); f32x4 ps = z4;
#pragma unroll
                for (int h = 0; h < 4; ++h) { f32x4 s = MFMA16(k0, qf[h][0], z4); s = MFMA16(k1, qf[h][1], s);
#pragma unroll
                    for (int j = 0; j < 4; ++j) { const int nk = 16 * kt + 4 * q + j; const bool v = (16 * kt + 15 < qt - 1) || (nk < qt - 1) || (nk == qt - 1 && r == 15); s[j] = v ? __expf(s[j] - m[h]) * rl[h] : 0.f; }
                    pp[h][hf] = s; ps += s; }
                const int J = 4 * kt + q; impA[r * 128 + J] = (ps[0] + ps[1]) + (ps[2] + ps[3]); if (J + 1 < 128) impB[r * 128 + J + 1] = ps[3];
            } else {
#pragma unroll
                for (int h = 0; h < 4; ++h) pp[h][hf] = z4; } }
#pragma unroll
        for (int dt = 0; dt < 4; ++dt) { const bf16x8 vf = ld8(Vc + (kp * 4 + dt) * 512);
#pragma unroll
            for (int h = 0; h < 4; ++h) oc[h][dt] = MFMA16(pack8(pp[h][0], pp[h][1]), vf, oc[h][dt]); } }
    LDS_WAIT();
    LAS unsigned char* selL = (LAS unsigned char*)sl;
    if (cur < 16) { for (int qi = 0; qi < 16; ++qi) { if (lane <= cur) selL[qi * 16 + lane] = (unsigned char)lane; if (lane == 0) selL[256 + qi] = (unsigned char)(cur + 1); } }
    else {
#pragma unroll
        for (int i = 0; i < 32; ++i) { const int idx = lane + 64 * i, jj = idx & 127; const float v = impA[idx] + impB[idx]; impA[idx] = (jj > cur) ? 0.0f : (jj == 0 || jj == cur || jj == cur - 1) ? 1e9f : v; }
        LDS_WAIT();
        for (int qi = 0; qi < 16; ++qi) { const LAS float* iv = impA + qi * 128; const unsigned k0 = __float_as_uint(iv[lane]), k1 = __float_as_uint(iv[lane + 64]); unsigned T = 0u;
#pragma unroll 1
            for (int bit = 30; bit >= 0; --bit) { const unsigned trial = T | (1u << bit); const int cntge = __popcll(__ballot(k0 >= trial)) + __popcll(__ballot(k1 >= trial)); if (cntge >= 16) T = trial; }
            const unsigned long long lt = (1ull << lane) - 1ull, mg0 = __ballot(k0 > T), mg1 = __ballot(k1 > T), me0 = __ballot(k0 == T), me1 = __ballot(k1 == T);
            const int need = 16 - (__popcll(mg0) + __popcll(mg1));
            const bool s0 = (k0 > T) || (k0 == T && __popcll(me0 & lt) < need), s1 = (k1 > T) || (k1 == T && __popcll(me0) + __popcll(me1 & lt) < need);
            const unsigned long long m0 = __ballot(s0), m1 = __ballot(s1);
            if (s0) selL[qi * 16 + __popcll(m0 & lt)] = (unsigned char)lane;
            if (s1) selL[qi * 16 + __popcll(m0) + __popcll(m1 & lt)] = (unsigned char)(lane + 64);
            if (lane == 0) selL[256 + qi] = (unsigned char)(__popcll(m0) + __popcll(m1)); } }
    LDS_WAIT();
#pragma unroll
    for (int h = 0; h < 4; ++h)
#pragma unroll
        for (int dt = 0; dt < 4; ++dt)
#pragma unroll
            for (int j = 0; j < 4; ++j) OACC[((4 * q + j) * 4 + h) * 64 + 16 * dt + r] = GL[(4 * q + j) * 12 + 3 * h] * oc[h][dt][j];
    LDS_WAIT();
    const unsigned char* Vs8b = c.Vs8 + (size_t)(b * 2 + g) * 128 * 4096; const unsigned char* Ks8b = c.Ks8 + (size_t)(b * 2 + g) * 128 * 4096;
#define SEL_LOAD(KF, VV, JB) do { const unsigned char* Kb_ = Ks8b + (size_t)(JB) * 4096 + lane * 16; const unsigned char* Vb_ = Vs8b + (size_t)(JB) * 4096 + lane * 16; \
        _Pragma("unroll") for (int f = 0; f < 4; ++f) { KF[f] = *(const u32x4*)(Kb_ + f * 1024); VV[f] = *(const u32x4*)(Vb_ + f * 1024); } } while (0)
#define SEL_COMPUTE(KF, VV, JB) do { f32x4 s_[4]; \
        _Pragma("unroll") for (int k4 = 0; k4 < 4; ++k4) { s_[k4] = MFMA8(mk64(KF[k4].x, KF[k4].y), qs8[0], z4); s_[k4] = MFMA8(mk64(KF[k4].z, KF[k4].w), qs8[1], s_[k4]); } \
        f32x4 sm = rho == 0 ? s_[0] : rho == 1 ? s_[1] : rho == 2 ? s_[2] : s_[3]; \
        if ((JB) == cur) { _Pragma("unroll") for (int j = 0; j < 4; ++j) if (64 * (JB) + 16 * rho + 4 * q + j > t) sm[j] = -1e30f; } \
        float tm = fmaxf(fmaxf(sm[0], sm[1]), fmaxf(sm[2], sm[3])); \
        tm = fmaxf(tm, pg8::dppf<0x124>(tm, tm)); tm = fmaxf(tm, pg8::dppf<0x128>(tm, tm)); tm = fmaxf(tm, __shfl_xor(tm, 16)); tm = fmaxf(tm, __shfl_xor(tm, 32)); \
        if (__ballot(tm > ms) != 0ull) { const float mn = fmaxf(ms, tm), al = __expf((ms - mn) * 0.125f); ms = mn; lsum *= al; const f32x4 av = (f32x4){rdlane(al, 0), rdlane(al, 1), rdlane(al, 2), rdlane(al, 3)}; \
            _Pragma("unroll") for (int dt = 0; dt < 4; ++dt) os[dt] *= av; } \
        const float msb = ms - 8.0f * 5.5451775f;     \
        const float p0 = __expf((sm[0] - msb) * 0.125f), p1 = __expf((sm[1] - msb) * 0.125f), p2 = __expf((sm[2] - msb) * 0.125f), p3 = __expf((sm[3] - msb) * 0.125f); lsum += (p0 + p1) + (p2 + p3); \
        const unsigned pk = pk4fp8(p0, p1, p2, p3); const long a0 = mk64(pk & me0, pk & mo0), a1 = mk64(pk & me1, pk & mo1); \
        _Pragma("unroll") for (int dt = 0; dt < 4; ++dt) { const u32x4 v0 = VV[dt >> 1], v1 = VV[2 + (dt >> 1)]; \
            os[dt] = MFMA8(a0, (dt & 1) ? mk64(v0.z, v0.w) : mk64(v0.x, v0.y), os[dt]); os[dt] = MFMA8(a1, (dt & 1) ? mk64(v1.z, v1.w) : mk64(v1.x, v1.y), os[dt]); } } while (0)
    const int rho = r >> 2; const unsigned me0 = rho == 0 ? 0xffffffffu : 0u, mo0 = rho == 1 ? 0xffffffffu : 0u, me1 = rho == 2 ? 0xffffffffu : 0u, mo1 = rho == 3 ? 0xffffffffu : 0u;
    for (int qi = 0; qi < 16; ++qi) { const int t = t0 + qi, cnt = __builtin_amdgcn_readfirstlane((int)selL[256 + qi]);
        long qs8[2];
#pragma unroll
        for (int ks = 0; ks < 2; ++ks) { const u32x4 w = __builtin_bit_cast(u32x4, ld8(Pb + (size_t)t * PLD + C_Q + (4 * g + (r & 3)) * 64 + 32 * ks + 8 * q));
            qs8[ks] = mk64(pk4fp8(__uint_as_float(w.x << 16), __uint_as_float(w.x & 0xffff0000u), __uint_as_float(w.y << 16), __uint_as_float(w.y & 0xffff0000u)),
                           pk4fp8(__uint_as_float(w.z << 16), __uint_as_float(w.z & 0xffff0000u), __uint_as_float(w.w << 16), __uint_as_float(w.w & 0xffff0000u))); }
        float ms = -1e30f, lsum = 0.f; f32x4 os[4];
#pragma unroll
        for (int dt = 0; dt < 4; ++dt) os[dt] = z4;
        u32x4 kfA[4], kfB[4], vvA[4], vvB[4];
        int bi = 0, jbA = __builtin_amdgcn_readfirstlane((int)selL[qi * 16]), jbB = jbA;
        SEL_LOAD(kfA, vvA, jbA);
        for (;;) {
            if (bi + 1 < cnt) { jbB = __builtin_amdgcn_readfirstlane((int)selL[qi * 16 + bi + 1]); SEL_LOAD(kfB, vvB, jbB); }
            SEL_COMPUTE(kfA, vvA, jbA);
            if (++bi >= cnt) break;
            if (bi + 1 < cnt) { jbA = __builtin_amdgcn_readfirstlane((int)selL[qi * 16 + bi + 1]); SEL_LOAD(kfA, vvA, jbA); }
            SEL_COMPUTE(kfB, vvB, jbB);
            if (++bi >= cnt) break; }
        lsum += pg8::dppf<0x124>(lsum, lsum); lsum += pg8::dppf<0x128>(lsum, lsum); lsum += __shfl_xor(lsum, 16); lsum += __shfl_xor(lsum, 32);
#pragma unroll
        for (int dt = 0; dt < 4; ++dt)
#pragma unroll
            for (int j = 0; j < 4; ++j) { float v = os[dt][j]; v += __shfl_xor(v, 16); v += __shfl_xor(v, 32); os[dt][j] = v; }
        const float l0 = rdlane(lsum, 0), l1 = rdlane(lsum, 1), l2 = rdlane(lsum, 2), l3 = rdlane(lsum, 3);
        const float lq = q == 0 ? l0 : q == 1 ? l1 : q == 2 ? l2 : l3; const float gsc = GL[qi * 12 + 3 * q + 1] / lq;
#pragma unroll
        for (int dt = 0; dt < 4; ++dt) { const float v = q == 0 ? os[dt][0] : q == 1 ? os[dt][1] : q == 2 ? os[dt][2] : os[dt][3]; OACC[(qi * 4 + q) * 64 + 16 * dt + r] += gsc * v; } }
#undef SEL_LOAD
#undef SEL_COMPUTE
    LDS_WAIT();
    LOAD_QF();
#undef LOAD_QF
    float mw[4], lw[4]; f32x4 ow[4][4];
#pragma unroll
    for (int h = 0; h < 4; ++h) { mw[h] = -1e30f; lw[h] = 0.f;
#pragma unroll
        for (int dt = 0; dt < 4; ++dt) ow[h][dt] = z4; }
    const bf16_t* VwTb = c.VwT + (size_t)(b * 2 + g) * 128 * 4096; const bf16_t* KwCb = c.KwC + (size_t)(b * 2 + g) * S * 64; const int tq = t0 + r;
    for (int ke = (t0 - 512) & ~31; ke <= t0; ke += 32) { if (ke < 0) continue; f32x4 pp[4][2];
        const size_t boff = (size_t)(ke >> 6) * 4096 + lane * 8; const int kp2 = (ke & 63) >> 5; const bool fullw = (ke + 31 <= t0) && (ke >= t0 - 496);
        bf16x8 kf[2][2], vf[4];
#pragma unroll
        for (int hf = 0; hf < 2; ++hf) { kf[hf][0] = ld8(KwCb + boff + ((2 * kp2 + hf) * 2) * 512); kf[hf][1] = ld8(KwCb + boff + ((2 * kp2 + hf) * 2 + 1) * 512); }
#pragma unroll
        for (int dt = 0; dt < 4; ++dt) vf[dt] = ld8(VwTb + boff + (kp2 * 4 + dt) * 512);
#pragma unroll
        for (int hf = 0; hf < 2; ++hf) { const int k0t = ke + 16 * hf;
#pragma unroll
            for (int h = 0; h < 4; ++h) { f32x4 s = MFMA16(kf[hf][0], qf[h][0], z4); s = MFMA16(kf[hf][1], qf[h][1], s);
                if (!fullw) {
#pragma unroll
                    for (int j = 0; j < 4; ++j) { const int kk = k0t + 4 * q + j; if (kk > tq || kk <= tq - 512) s[j] = -1e30f; } }
                pp[h][hf] = s; } }
        bf16x8 pa[4];
#pragma unroll
        for (int h = 0; h < 4; ++h) { float tm = -1e30f;
#pragma unroll
            for (int j = 0; j < 4; ++j) tm = fmaxf(tm, fmaxf(pp[h][0][j], pp[h][1][j]));
            tm = fmaxf(tm, __shfl_xor(tm, 16)); tm = fmaxf(tm, __shfl_xor(tm, 32));
            if (__ballot(tm > mw[h]) != 0ull) {
                const float mn = fmaxf(mw[h], tm), al = __expf(mw[h] - mn); mw[h] = mn; lw[h] *= al;
                const f32x4 av = (f32x4){__shfl(al, 4 * q), __shfl(al, 4 * q + 1), __shfl(al, 4 * q + 2), __shfl(al, 4 * q + 3)};
#pragma unroll
                for (int dt = 0; dt < 4; ++dt) ow[h][dt] *= av; }
            const float mn = mw[h]; float ps = 0.f;
#pragma unroll
            for (int hf = 0; hf < 2; ++hf)
#pragma unroll
                for (int j = 0; j < 4; ++j) { const float p = pp[h][hf][j] > -1e29f ? __expf(pp[h][hf][j] - mn) : 0.f; pp[h][hf][j] = p; ps += p; }
            lw[h] += ps;
            pa[h] = pack8(pp[h][0], pp[h][1]); }
#pragma unroll
        for (int dt = 0; dt < 4; ++dt)
#pragma unroll
            for (int h = 0; h < 4; ++h) ow[h][dt] = MFMA16(pa[h], vf[dt], ow[h][dt]); }
#pragma unroll
    for (int h = 0; h < 4; ++h) { lw[h] += __shfl_xor(lw[h], 16); lw[h] += __shfl_xor(lw[h], 32);
        const f32x4 lr = (f32x4){__shfl(lw[h], 4 * q), __shfl(lw[h], 4 * q + 1), __shfl(lw[h], 4 * q + 2), __shfl(lw[h], 4 * q + 3)};
#pragma unroll
        for (int dt = 0; dt < 4; ++dt)
#pragma unroll
            for (int j = 0; j < 4; ++j) { const int qi = 4 * q + j; const float val = OACC[(qi * 4 + h) * 64 + 16 * dt + r] + GL[qi * 12 + 3 * h + 2] * ow[h][dt][j] / lr[j];
                c.CAT[(rowb + t0 + qi) * D + 1024 + (4 * g + h) * 64 + 16 * dt + r] = f2bf1(val); } }
    LDS_WAIT();
}
__device__ __forceinline__ void mem_item(const Ctx& c, int item, int lane) {
    const int qt = item & 511, h = (item >> 9) & 3, b = item >> 11, r = lane & 15, q = lane >> 4; const size_t rowb = (size_t)b * S + 16 * qt;
    const f32x4 z4 = (f32x4){0.f, 0.f, 0.f, 0.f};
    bf16x8 qm[4];
#pragma unroll
    for (int ks = 0; ks < 4; ++ks) qm[ks] = ld8(c.P + (rowb + r) * PLD + C_MQ + 128 * h + 32 * ks + 8 * q);
    f32x4 s[16]; float mx = -1e30f;
#pragma unroll
    for (int kt = 0; kt < 16; ++kt) { s[kt] = z4; const bf16_t* kp = c.MK + (size_t)(b * 4 + h) * 32768 + kt * 2048 + lane * 8;
#pragma unroll
        for (int ks = 0; ks < 4; ++ks) s[kt] = MFMA16(ld8(kp + 512 * ks), qm[ks], s[kt]);
        s[kt] *= 0.08838834764831845f;
#pragma unroll
        for (int j = 0; j < 4; ++j) mx = fmaxf(mx, s[kt][j]); }
    mx = fmaxf(mx, __shfl_xor(mx, 16)); mx = fmaxf(mx, __shfl_xor(mx, 32)); float ls = 0.f;
#pragma unroll
    for (int kt = 0; kt < 16; ++kt)
#pragma unroll
        for (int j = 0; j < 4; ++j) { s[kt][j] = __expf(s[kt][j] - mx); ls += s[kt][j]; }
    ls += __shfl_xor(ls, 16); ls += __shfl_xor(ls, 32);
    f32x4 o[8];
#pragma unroll
    for (int dt = 0; dt < 8; ++dt) o[dt] = z4;
#pragma unroll
    for (int kp = 0; kp < 8; ++kp) { const bf16x8 pa = pack8(s[2 * kp], s[2 * kp + 1]);
#pragma unroll
        for (int dt = 0; dt < 8; ++dt) o[dt] = MFMA16(pa, ld8(c.MVT + (size_t)(b * 4 + h) * 32768 + (kp * 8 + dt) * 512 + lane * 8), o[dt]); }
    const f32x4 lr = (f32x4){__shfl(ls, 4 * q), __shfl(ls, 4 * q + 1), __shfl(ls, 4 * q + 2), __shfl(ls, 4 * q + 3)};
#pragma unroll
    for (int dt = 0; dt < 8; ++dt)
#pragma unroll
        for (int j = 0; j < 4; ++j) c.CAT[(rowb + 4 * q + j) * D + 1536 + 128 * h + 16 * dt + r] = f2bf1(o[dt][j] / lr[j]);
}
__global__ void __launch_bounds__(512, 2) hymba_fwd(Args a) {
    extern __shared__ __attribute__((aligned(16))) unsigned char lds_raw[];
    LAS unsigned char* lds = (LAS unsigned char*)lds_raw;
    cg::grid_group grid = cg::this_grid();
    Ctx c;
    c.x = a.in[0]; c.mem = a.in[1]; c.ln_in_g = a.in[2]; c.ln_in_b = a.in[3]; c.w_in = a.in[4]; c.lru_cw = a.in[5]; c.lru_cb = a.in[6]; c.lru_wa = a.in[7]; c.lru_ba = a.in[8]; c.lru_wx = a.in[9]; c.lru_bx = a.in[10];
    c.lru_lam = a.in[11]; c.pe_k = a.in[12]; c.w1k = a.in[13]; c.w2k = a.in[14]; c.pe_v = a.in[15]; c.w1v = a.in[16]; c.w2v = a.in[17]; c.w_mem = a.in[18]; c.w_out = a.in[19]; c.ln1_g = a.in[20]; c.ln1_b = a.in[21];
    c.w_up = a.in[22]; c.fcw = a.in[23]; c.fcb = a.in[24]; c.w_down = a.in[25]; c.ln2_g = a.in[26]; c.ln2_b = a.in[27]; c.out = a.out;
    unsigned char* ws = a.ws;
    c.WinT = (bf16_t*)(ws + WS_WIN); c.WoutT = (bf16_t*)(ws + WS_WOUT); c.WupT = (bf16_t*)(ws + WS_WUP); c.WdownT = (bf16_t*)(ws + WS_WDOWN); c.WmemT = (bf16_t*)(ws + WS_WMEM); c.MEMB = (bf16_t*)(ws + WS_MEMB);
    c.WaT = (bf16_t*)(ws + WS_WAT); c.WxT = (bf16_t*)(ws + WS_WXT); c.W1kT = (bf16_t*)(ws + WS_W1K); c.W1vT = (bf16_t*)(ws + WS_W1V); c.W2kT = (bf16_t*)(ws + WS_W2K); c.W2vT = (bf16_t*)(ws + WS_W2V);
    c.MK = (bf16_t*)(ws + WS_MK); c.MVT = (bf16_t*)(ws + WS_MVT); c.KCMP = (bf16_t*)(ws + WS_KCMP); c.VCMPT = (bf16_t*)(ws + WS_VCMPT); c.AGG = (float2*)(ws + WS_AGG); c.VsT = (bf16_t*)(ws + WS_VST); c.VwT = (bf16_t*)(ws + WS_VWT); c.KsC = (bf16_t*)(ws + WS_KSC); c.KwC = (bf16_t*)(ws + WS_KWC);
    c.STAT0 = (float2*)(ws + WS_STAT0); c.STAT1 = (float2*)(ws + WS_STAT1); c.Ks8 = ws + WS_KS8; c.Vs8 = ws + WS_VS8; c.LA = (float*)(ws + WS_LA); c.LU = (float*)(ws + WS_LU); c.MIX = (bf16_t*)(ws + WS_MIX); c.FFN = (bf16_t*)(ws + WS_FFN); c.H0B = (bf16_t*)(ws + WS_H0B); c.P = (bf16_t*)(ws + WS_P); c.CAT = (bf16_t*)(ws + WS_CAT); c.H1B = (bf16_t*)(ws + WS_H1B); c.ACT = (bf16_t*)(ws + WS_ACT);
    const int tid = threadIdx.x, lane = tid & 63, wave = __builtin_amdgcn_readfirstlane(tid >> 6), G = gridDim.x, gw = blockIdx.x * 8 + wave, NGW = G * 8;
    const int lo = a.ph_lo, hi = a.ph_hi;
#define IN(k) (lo <= (k) && (k) < hi)
    volatile LAS unsigned* bst = (volatile LAS unsigned*)(lds + 147392);
    if (tid < 2) bst[tid] = 0u;
    __syncthreads();
    if (blockIdx.x == 0) for (int i = tid; i < 4096; i += 512) ((unsigned*)ws)[i] = 0u;
    XcdBarrier xbar; xbar.bar = (unsigned*)ws; xbar.x = 0; xbar.st = bst;
#define SEAM(k) do { if (IN(k) && IN((k) + 1)) { if ((k) == 0) { grid.sync(); xbar = xcd_barrier_post((unsigned*)ws, bst); } else xcd_barrier(xbar); } } while (0)
    if (IN(0)) phase0(c, lds, gw, NGW, wave, lane);
    SEAM(0);
    if (IN(1)) { pg8::Gemm g{c.H0B, c.WinT, T, NINP, D, 0}; pg8::StaticOrder so; so.init(T, NINP, G, (int)blockIdx.x); pg8::EpiBf16<0> E{c.P, PLD, nullptr, 0, 0};
        pg8::gemm_phase<pg8::EpiBf16<0>, pg8::StaticOrder, false>(lds, g, so, E, nullptr); }
    SEAM(1);
    if (IN(2)) {
        for (int bt = blockIdx.x; bt < 256; bt += G) vt_tile(c, lds, bt, tid);
        for (int base = blockIdx.x * 8; base < 2048; base += G * 8) lru_walk1(c, lds, base, tid);
        for (int task = gw; task < 2048; task += NGW) memkv_task(c, task, lane);
        for (int task = blockIdx.x; task < 256; task += G) compress_task(c, lds, task, tid);
    }
    SEAM(2);
    if (IN(3)) {
        for (int base = blockIdx.x * 8; base < 2048; base += G * 8) lru_walk2(c, lds, base, tid);
        {
          const int xcd = blockIdx.x & 7, slot = blockIdx.x >> 3;
          const int item0 = (G == 256) ? (((xcd & 3) << 9) | (((slot * 8 + wave) << 1) | (xcd >> 2))) : gw, istep = (G == 256) ? 4096 : NGW;
          for (int item = item0; item < 2048; item += istep) nsa_item(c, lds + wave * 16384, lds + 131072 + wave * 1280, item, lane); }
        { unsigned* qctr = (unsigned*)ws + 3584;
          for (;;) { int item = 0; if (lane == 0) item = (int)atomicAdd(qctr, 1u); item = __builtin_amdgcn_readfirstlane(item); if (item >= 4096) break; mem_item(c, item, lane); } }
    }
    SEAM(3);
    if (IN(4)) { pg8::Gemm g{c.CAT, c.WoutT, T, D, D, 0}; pg8::StaticOrder so; so.init(T, D, G, (int)blockIdx.x); pg8::EpiBf16<0> E{c.MIX, D, nullptr, 0, 0};
        pg8::gemm_phase<pg8::EpiBf16<0>, pg8::StaticOrder, false>(lds, g, so, E, nullptr); }
    SEAM(4);
    if (IN(5)) { for (int m = gw; m < T; m += 2 * NGW) ln_fuse_rows<2>(c.x, c.STAT0, c.ln_in_g, c.ln_in_b, c.MIX, c.out, c.ln1_g, c.ln1_b, nullptr, c.H1B, c.STAT1, m, NGW, lane); }
    SEAM(5);
    if (IN(6)) { pg8::Gemm g{c.H1B, c.WupT, 66 * 256, 2 * DFF, D, 1}; pg8::StaticOrder so; so.init(66 * 256, 2 * DFF, G, (int)blockIdx.x, 5); pg8::EpiConvGeglu E{c.ACT, c.fcw, c.fcb, (LAS float*)(lds + EX_OFF)};
        pg8::gemm_phase<pg8::EpiConvGeglu, pg8::StaticOrder, false>(lds, g, so, E, nullptr);
        const int first = (66 * 44) % G, nw = (G - first) * 8;
        if ((int)blockIdx.x >= first) for (int it = ((int)blockIdx.x - first) * 8 + wave; it < 88 * 32; it += nw) transpose_item<0>(c.w_down, 5632, 2048, c.WdownT, (LAS float*)(lds + wave * 16640), it, 32, lane); }
    SEAM(6);
    if (IN(7)) { pg8::Gemm g{c.ACT, c.WdownT, T, D, DFF, 0}; pg8::StaticOrder so; so.init(T, D, G, (int)blockIdx.x, 16); pg8::EpiBf16<0> E{c.FFN, D, nullptr, 0, 0};
        pg8::gemm_phase<pg8::EpiBf16<0>, pg8::StaticOrder, false>(lds, g, so, E, nullptr); }
    SEAM(7);
    if (IN(8)) { for (int m = gw; m < T; m += 2 * NGW) ln_fuse_rows<2>(c.out, c.STAT1, c.ln1_g, c.ln1_b, c.FFN, nullptr, c.ln2_g, c.ln2_b, c.out, nullptr, nullptr, m, NGW, lane); }
#undef IN
#undef SEAM
}

extern "C" void kernel_launch(void* const* d_in, const int* in_sizes, int n_in, void* d_out, int out_size, void* d_ws, size_t ws_size, hipStream_t stream) {
    static int grid = 0;
    if (grid == 0) {
        if (n_in != 28 || out_size != T * D || ws_size < WS_END) { fprintf(stderr, "kernel_launch: unexpected shapes (n_in %d, out %d, ws %zu)\n", n_in, out_size, ws_size); grid = -1; return; }
        int dev = 0, cus = 0, per_cu = 0;
        (void)hipGetDevice(&dev); (void)hipDeviceGetAttribute(&cus, hipDeviceAttributeMultiprocessorCount, dev);
        if (hipFuncSetAttribute((const void*)hymba_fwd, hipFuncAttributeMaxDynamicSharedMemorySize, LDS_BYTES) != hipSuccess) { fprintf(stderr, "kernel_launch: hipFuncSetAttribute failed\n"); grid = -1; return; }
        if (hipOccupancyMaxActiveBlocksPerMultiprocessor(&per_cu, (const void*)hymba_fwd, 512, LDS_BYTES) != hipSuccess || per_cu < 1) per_cu = 1;
        (void)hipGetLastError();
        grid = cus * per_cu;
        fprintf(stderr, "kernel_launch: grid %d (cus %d x %d)\n", grid, cus, per_cu);
    }
    if (grid < 0) return;
    Args a{};
    for (int i = 0; i < 28; ++i) a.in[i] = (const float*)d_in[i];
    a.out = (float*)d_out; a.ws = (unsigned char*)d_ws; a.ph_lo = 0; a.ph_hi = 9;
    void* args[] = {&a};
    const hipError_t e = hipLaunchCooperativeKernel((void*)hymba_fwd, dim3(grid), dim3(512), args, LDS_BYTES, stream);
    if (e != hipSuccess) fprintf(stderr, "kernel_launch: cooperative launch failed: %s (grid %d)\n", hipGetErrorString(e), grid);
}
```

```cpp
#include <hip/hip_runtime.h>
#include <hip/hip_cooperative_groups.h>
#include <cstdio>
namespace cg = cooperative_groups;
namespace pg8 {
#define PG8_LAS __attribute__((address_space(3)))
typedef unsigned short bf16_t;
typedef short bf16x8 __attribute__((ext_vector_type(8)));
typedef float f32x4 __attribute__((ext_vector_type(4)));
typedef unsigned u32x4 __attribute__((ext_vector_type(4)));
constexpr int BM = 256, BK = 64, HALF = 128, HTB = HALF * BK * 2  , STAGE_BYTES = 8 * HTB, NXCD = 8, WGM = 4;

__host__ __device__ __forceinline__ int lds_byte(int r, int c) { const int st = (r >> 4) * 2 + (c >> 5), rr = r & 15, cc = c & 31, ob = rr * 64 + cc * 2; return st * 1024 + (ob ^ (((ob >> 9) & 1) << 5)); }
__host__ __device__ __forceinline__ void stage_rc(int b, int& R, int& C) { const int st = b / 1024, sb = b % 1024, swz = sb ^ (((sb >> 9) & 1) << 5); R = (st >> 1) * 16 + swz / 64; C = (st & 1) * 32 + (swz % 64) / 2; }
__host__ __device__ __forceinline__ int perm32(int rho) { const int n = rho >> 4, i = rho & 15; return 8 * (i >> 2) + 4 * n + (i & 3); }

struct Unit { int pm, pn; };
struct Gemm { const bf16_t* A; const bf16_t* Bt; int M, N, K; int halo; };
__device__ __forceinline__ long long a_off(const Gemm& g, int pm) { return g.halo ? ((long long)((pm / 33) * 8192 + (pm % 33) * 254 - 2) * g.K * 2) : ((long long)pm * 256 * g.K * 2); }

struct StaticOrder {
    int nM, nN, nwg, G, c, wgm;
    __host__ __device__ void init(int M, int N, int G_, int c_, int wgm_ = WGM) { nM = M / BM; nN = N / BM; nwg = nM * nN; G = G_; c = c_; wgm = wgm_; }
    __host__ __device__ bool next(int i, Unit& u) const {
        const long L = (long)i * G + c; if (L >= nwg) return false;
        int wgid = (int)L; { const int q = nwg / NXCD, r = nwg % NXCD, xcd = wgid % NXCD, off = wgid / NXCD; wgid = (xcd < r ? xcd * (q + 1) : r * (q + 1) + (xcd - r) * q) + off; }
        const int nig = wgm * nN, gid = wgid / nig, fm = gid * wgm, gsz = (nM - fm) < wgm ? (nM - fm) : wgm;
        u.pm = fm + ((wgid % nig) % gsz); u.pn = (wgid % nig) / gsz; return true;
    }
    __device__ __forceinline__ void a_ready(const Unit&) const {}
    __device__ __forceinline__ void done(const Unit&) const {}
};
__device__ __forceinline__ unsigned cvt_pk_bf16(float lo, float hi) { unsigned r; asm volatile("v_cvt_pk_bf16_f32 %0, %1, %2" : "=v"(r) : "v"(lo), "v"(hi)); return r; }
typedef float f32x2 __attribute__((ext_vector_type(2)));
__device__ __forceinline__ f32x2 gelu_pk(f32x2 v) {
    const f32x2 av = __builtin_elementwise_abs(v), d = av * 0.2316418882f + 1.0f;
    f32x2 t; t.x = __builtin_amdgcn_rcpf(d.x); t.y = __builtin_amdgcn_rcpf(d.y);
    f32x2 q = t * 0.5307027145f + (-0.7265760135f); q = q * t + 0.7107068705f; q = q * t + (-0.142248368f); q = q * t + 0.127414796f; q = q * t;
    const f32x2 s = (v * v) * (-0.72134752044f);
    f32x2 e; e.x = __builtin_amdgcn_exp2f(s.x); e.y = __builtin_amdgcn_exp2f(s.y);
    const f32x2 m = v * (q * e), r = v - m;
    f32x2 o; o.x = v.x < 0.f ? m.x : r.x; o.y = v.y < 0.f ? m.y : r.y; return o;
}

template <int ACT  > struct EpiBf16 {
    static constexpr bool PERM = true, AFTER_DRAIN = false;
    bf16_t* O; int ldc; const float* bias; int split_cols; size_t split_stride;
    __device__ __forceinline__ void operator()(const f32x4 (&acc)[2][2][4][2], const Unit& u, int wr, int wc, int fr, int fq) const {
        const int row0 = u.pm * BM + wr * 64 + fr; int colt = u.pn * BM; bf16_t* base = O;
        if (split_cols) { const int t = colt / split_cols; base += (size_t)t * split_stride; colt -= t * split_cols; }
        const int col0 = colt + wc * 32 + 8 * fq, bcol0 = u.pn * BM + wc * 32 + 8 * fq;
        f32x4 bv[2][2];
#pragma unroll
        for (int bj = 0; bj < 2; ++bj)
#pragma unroll
            for (int n = 0; n < 2; ++n) bv[bj][n] = bias ? *(const f32x4*)(bias + bcol0 + bj * HALF + 4 * n) : (f32x4){0.f, 0.f, 0.f, 0.f};
#pragma unroll
        for (int ai = 0; ai < 2; ++ai)
#pragma unroll
            for (int m = 0; m < 4; ++m) { bf16_t* rowp = base + (size_t)(row0 + ai * HALF + m * 16) * ldc + col0;
#pragma unroll
                for (int bj = 0; bj < 2; ++bj) { f32x4 v0 = acc[ai][bj][m][0] + bv[bj][0], v1 = acc[ai][bj][m][1] + bv[bj][1];
                    if (ACT == 1) { f32x2 a = gelu_pk((f32x2){v0[0], v0[1]}), b = gelu_pk((f32x2){v0[2], v0[3]}), c = gelu_pk((f32x2){v1[0], v1[1]}), d = gelu_pk((f32x2){v1[2], v1[3]});
                        v0 = (f32x4){a.x, a.y, b.x, b.y}; v1 = (f32x4){c.x, c.y, d.x, d.y}; }
                    if (ACT == 2) {
#pragma unroll
                        for (int j = 0; j < 4; ++j) { v0[j] = 0.5f * v0[j] * (1.0f + erff(v0[j] * 0.70710678f)); v1[j] = 0.5f * v1[j] * (1.0f + erff(v1[j] * 0.70710678f)); } }
                    u32x4 w; w.x = cvt_pk_bf16(v0[0], v0[1]); w.y = cvt_pk_bf16(v0[2], v0[3]); w.z = cvt_pk_bf16(v1[0], v1[1]); w.w = cvt_pk_bf16(v1[2], v1[3]);
                    *(u32x4*)(rowp + bj * HALF) = w; } }
    }
};
struct EpiResF32 {
    static constexpr bool PERM = false, AFTER_DRAIN = false;
    float* C; const float* base; int ldc; float alpha;
    __device__ __forceinline__ void operator()(const f32x4 (&acc)[2][2][4][2], const Unit& u, int wr, int wc, int fr, int fq) const {
        const int row0 = u.pm * BM + wr * 64 + fr, col0 = u.pn * BM + wc * 32 + 4 * fq;
#pragma unroll
        for (int ai = 0; ai < 2; ++ai)
#pragma unroll
            for (int m = 0; m < 4; ++m) { const size_t off = (size_t)(row0 + ai * HALF + m * 16) * ldc + col0;
#pragma unroll
                for (int bj = 0; bj < 2; ++bj)
#pragma unroll
                    for (int n = 0; n < 2; ++n) { const f32x4 bs = *(const f32x4*)(base + off + bj * HALF + n * 16); *(f32x4*)(C + off + bj * HALF + n * 16) = bs * alpha + acc[ai][bj][m][n]; } }
    }
};
struct EpiResLnF32 {
    static constexpr bool PERM = false, AFTER_DRAIN = false;
    float* C; const float* base; const float2* stats; const float* g; const float* b; int ldc; float alpha;
    __device__ __forceinline__ void operator()(const f32x4 (&acc)[2][2][4][2], const Unit& u, int wr, int wc, int fr, int fq) const {
        const int row0 = u.pm * BM + wr * 64 + fr, col0 = u.pn * BM + wc * 32 + 4 * fq;
        f32x4 gv[2][2], bv[2][2];
#pragma unroll
        for (int bj = 0; bj < 2; ++bj)
#pragma unroll
            for (int n = 0; n < 2; ++n) { gv[bj][n] = *(const f32x4*)(g + col0 + bj * HALF + n * 16) * alpha; bv[bj][n] = *(const f32x4*)(b + col0 + bj * HALF + n * 16) * alpha; }
#pragma unroll
        for (int ai = 0; ai < 2; ++ai)
#pragma unroll
            for (int m = 0; m < 4; ++m) { const int row = row0 + ai * HALF + m * 16; const size_t off = (size_t)row * ldc + col0; const float2 st = stats[row];
#pragma unroll
                for (int bj = 0; bj < 2; ++bj)
#pragma unroll
                    for (int n = 0; n < 2; ++n) { const f32x4 bs = *(const f32x4*)(base + off + bj * HALF + n * 16); *(f32x4*)(C + off + bj * HALF + n * 16) = ((bs - st.x) * st.y) * gv[bj][n] + bv[bj][n] + acc[ai][bj][m][n]; } }
    }
};
template <int CTRL> __device__ __forceinline__ float dppf(float old, float src) {
    return __builtin_bit_cast(float, __builtin_amdgcn_update_dpp(__builtin_bit_cast(int, old), __builtin_bit_cast(int, src), CTRL, 0xf, 0xf, false));
}
__device__ __forceinline__ float gelu_tanh(float x) {
    const float u = 1.5957691216f * (x + 0.044715f * x * x * x);
    return x * __builtin_amdgcn_rcpf(1.0f + __expf(-u));
}
struct EpiConvGeglu {
    static constexpr bool PERM = true, AFTER_DRAIN = false;
    bf16_t* ACT; const float* cw; const float* cb; PG8_LAS float* EX;
    __device__ __forceinline__ void operator()(const f32x4 (&acc)[2][2][4][2], const Unit& u, int wr, int wc, int fr, int fq) const {
        const int b = u.pm / 33, j = u.pm % 33, colu = wc * 32 + 8 * fq;
        if (fr >= 14) {
#pragma unroll
            for (int ai = 0; ai < 2; ++ai)
#pragma unroll
                for (int bj = 0; bj < 2; ++bj)
#pragma unroll
                    for (int n = 0; n < 2; ++n) *(PG8_LAS f32x4*)(EX + ((ai * 2 + wr) * 2 + (fr - 14)) * 256 + bj * 128 + colu + 4 * n) = acc[ai][bj][3][n];
        }
        f32x4 wgs[2][3], wus[2][3], bgs[2], bus[2];
#define CG_LOADP(N_) do { const int ca_ = u.pn * 128 + colu + 4 * (N_); _Pragma("unroll") for (int k = 0; k < 3; ++k) { wgs[N_][k] = *(const f32x4*)(cw + k * 11264 + ca_); wus[N_][k] = *(const f32x4*)(cw + k * 11264 + 5632 + ca_); } \
            bgs[N_] = *(const f32x4*)(cb + ca_); bus[N_] = *(const f32x4*)(cb + 5632 + ca_); } while (0)
        CG_LOADP(0); CG_LOADP(1);
        asm volatile("s_waitcnt lgkmcnt(0)" ::: "memory"); __builtin_amdgcn_s_barrier(); __builtin_amdgcn_s_barrier(); asm volatile("" ::: "memory");
        const int tb = j * 254 - 2; const bool zr = (j == 0) && (wr == 0) && (fr < 2);
        const f32x4 z4 = (f32x4){0.f, 0.f, 0.f, 0.f};
        const int ca = u.pn * 128 + colu;
#pragma unroll
        for (int ai = 0; ai < 2; ++ai) {
            f32x4 pg[2], pu[2];
#pragma unroll
            for (int n = 0; n < 2; ++n) { pg[n] = z4; pu[n] = z4;
                if (!(ai == 0 && wr == 0)) { const int slot = (wr == 1) ? (ai * 2) : ((ai - 1) * 2 + 1);
                    pg[n] = *(const PG8_LAS f32x4*)(EX + (slot * 2 + (fr & 1)) * 256 + colu + 4 * n); pu[n] = *(const PG8_LAS f32x4*)(EX + (slot * 2 + (fr & 1)) * 256 + 128 + colu + 4 * n); } }
#pragma unroll
            for (int m = 0; m < 4; ++m) { u32x4 w;
#pragma unroll
                for (int n = 0; n < 2; ++n) {
                    f32x4 xg = acc[ai][0][m][n], xu = acc[ai][1][m][n];
                    if (ai == 0 && m == 0 && zr) { xg = z4; xu = z4; }
                    f32x4 g1, g2, u1, u2;
#pragma unroll
                    for (int e = 0; e < 4; ++e) { g1[e] = dppf<0x111>(dppf<0x121>(0.f, pg[n][e]), xg[e]); g2[e] = dppf<0x112>(dppf<0x122>(0.f, pg[n][e]), xg[e]);
                        u1[e] = dppf<0x111>(dppf<0x121>(0.f, pu[n][e]), xu[e]); u2[e] = dppf<0x112>(dppf<0x122>(0.f, pu[n][e]), xu[e]); }
                    const f32x4 cg = bgs[n] + wgs[n][0] * g2 + wgs[n][1] * g1 + wgs[n][2] * xg, cu = bus[n] + wus[n][0] * u2 + wus[n][1] * u1 + wus[n][2] * xu;
                    const f32x4 zz = cg * ((cg * cg) * 0.10294324f + 2.3022082f);
                    f32x4 dn;
#pragma unroll
                    for (int e = 0; e < 4; ++e) dn[e] = __builtin_amdgcn_exp2f(-zz[e]);
                    dn = dn + 1.0f;
#pragma unroll
                    for (int e = 0; e < 4; ++e) dn[e] = __builtin_amdgcn_rcpf(dn[e]);
                    const f32x4 a4 = (cg * cu) * dn;
                    pg[n] = xg; pu[n] = xu;
                    if (n == 0) { w.x = cvt_pk_bf16(a4[0], a4[1]); w.y = cvt_pk_bf16(a4[2], a4[3]); } else { w.z = cvt_pk_bf16(a4[0], a4[1]); w.w = cvt_pk_bf16(a4[2], a4[3]); }
                }
                const int tr = ai * 128 + wr * 64 + m * 16 + fr, t = tb + tr;
                if (tr >= 2 && t < 8192) *(u32x4*)(ACT + (size_t)(b * 8192 + t) * 5632 + ca) = w;
            }
        }
#undef CG_LOADP
    }
};
template <class Epi, class Sched, bool STAMP = false>
__device__ __forceinline__ void gemm_phase(PG8_LAS unsigned char* lds, const Gemm g, const Sched& S, const Epi& E, unsigned long long* stamps) {
    const int tid = threadIdx.x, wid = __builtin_amdgcn_readfirstlane(tid >> 6), lane = tid & 63, wr = wid >> 2, wc = wid & 3, fr = lane & 15, fq = lane >> 4;
    const int K = g.K, nt = K / BK;
    int ts_lo = 0, ts_hi = 0, nts = 0; const unsigned long long rt_entry = STAMP ? (unsigned long long)wall_clock64() : 0ull;
#define PG8_STAMP() do { if (STAMP && wid == 0 && nts < 64) { const unsigned long long _c = (unsigned long long)clock64(); \
        ts_lo = (lane == nts) ? (int)(unsigned)_c : ts_lo; ts_hi = (lane == nts) ? (int)(unsigned)(_c >> 32) : ts_hi; ++nts; } } while (0)
    PG8_STAMP();
    unsigned voffA[2], voffB[2];
#pragma unroll
    for (int i = 0; i < 2; ++i) { int R, C; stage_rc(tid * 16 + i * 8192, R, C); const int Rb = Epi::PERM ? ((R & ~31) + perm32(R & 31)) : R;
        voffA[i] = (unsigned)(R * K + C) * 2u; voffB[i] = (unsigned)(Rb * K + C) * 2u; }
    const size_t kstep = (size_t)(BK * 2);
    const size_t hstep = (size_t)HALF * K * 2;
    const size_t tstep = 2 * hstep;
    const unsigned ldsw = (unsigned)wid * 1024u;
    const int aoff = lds_byte(wr * 64 + fr, fq * 8), boff = lds_byte(wc * 32 + fr, fq * 8);
#define PG8_SA(b, h) (((b) * 2 + (h)) * HTB)
#define PG8_SB(b, h) ((4 + (b) * 2 + (h)) * HTB)
#define PG8_STAGE(bufoff, gbase, voff) do { _Pragma("unroll") for (int _i = 0; _i < 2; ++_i) \
        __builtin_amdgcn_global_load_lds((const unsigned*)((const char*)(gbase) + (voff)[_i]), (PG8_LAS unsigned*)(lds + (bufoff) + ldsw + _i * 8192), 16, 0, 0); } while (0)
#define PG8_LDA(dst, b, h) do { _Pragma("unroll") for (int m = 0; m < 4; ++m) _Pragma("unroll") for (int k = 0; k < 2; ++k) dst[m][k] = *(const PG8_LAS bf16x8*)(lds + PG8_SA(b, h) + aoff + m * 2048 + k * 1024); } while (0)
#define PG8_LDB(dst, b, h) do { _Pragma("unroll") for (int n = 0; n < 2; ++n) _Pragma("unroll") for (int k = 0; k < 2; ++k) dst[n][k] = *(const PG8_LAS bf16x8*)(lds + PG8_SB(b, h) + boff + n * 2048 + k * 1024); } while (0)
#define PG8_MMA(ai, bj, At, Bt) do { __builtin_amdgcn_s_setprio(1); _Pragma("unroll") for (int m = 0; m < 4; ++m) _Pragma("unroll") for (int n = 0; n < 2; ++n) _Pragma("unroll") for (int k = 0; k < 2; ++k) \
        acc[ai][bj][m][n] = __builtin_amdgcn_mfma_f32_16x16x32_bf16(Bt[n][k], At[m][k], acc[ai][bj][m][n], 0, 0, 0); __builtin_amdgcn_s_setprio(0); } while (0)
#define PG8_WAIT_V(n) asm volatile("s_waitcnt vmcnt(" #n ")" ::: "memory")
#define PG8_WAIT_L(n) asm volatile("s_waitcnt lgkmcnt(" #n ")" ::: "memory")
#define PG8_BAR __builtin_amdgcn_s_barrier()
#define PG8_SCHED __builtin_amdgcn_sched_barrier(0)
    Unit cur, nxt; int ui = 0;
    if (!S.next(0, cur)) return;
    f32x4 acc[2][2][4][2];
#pragma unroll
    for (int a = 0; a < 2; ++a)
#pragma unroll
        for (int b = 0; b < 2; ++b)
#pragma unroll
            for (int m = 0; m < 4; ++m)
#pragma unroll
                for (int n = 0; n < 2; ++n) acc[a][b][m][n] = (f32x4){0.f, 0.f, 0.f, 0.f};
    bf16x8 At[4][2], B0[2][2], B1[2][2];
    const char* cA = (const char*)g.A + a_off(g, cur.pm); const char* cB = (const char*)g.Bt + (size_t)cur.pn * tstep;
    S.a_ready(cur);
    PG8_STAGE(PG8_SB(0, 0), cB, voffB); PG8_STAGE(PG8_SA(0, 0), cA, voffA); PG8_STAGE(PG8_SB(0, 1), cB + hstep, voffB); PG8_STAGE(PG8_SA(0, 1), cA + hstep, voffA);
    if (wr == 1) PG8_BAR;
    PG8_WAIT_V(4); PG8_BAR;
    PG8_STAGE(PG8_SB(1, 0), cB + kstep, voffB); PG8_STAGE(PG8_SA(1, 0), cA + kstep, voffA); PG8_STAGE(PG8_SB(1, 1), cB + hstep + kstep, voffB);
    PG8_WAIT_V(6); PG8_BAR;
    PG8_STAMP();
    for (;;) {
        const bool has_next = S.next(ui + 1, nxt);
        const char* nA = has_next ? (const char*)g.A + a_off(g, nxt.pm) : cA; const char* nB = has_next ? (const char*)g.Bt + (size_t)nxt.pn * tstep : cB;
        for (int t = 0; t < nt; t += 2) {
            const bool last = (t == nt - 2);
            const char* a1 = cA + (size_t)(t + 1) * kstep;
            const char* a2 = last ? nA : cA + (size_t)(t + 2) * kstep; const char* b2 = last ? nB : cB + (size_t)(t + 2) * kstep;
            const char* a3 = a2 + kstep; const char* b3 = b2 + kstep;
            if (last && has_next) S.a_ready(nxt);
            PG8_LDB(B0, 0, 0); PG8_SCHED; PG8_LDA(At, 0, 0); PG8_STAGE(PG8_SA(1, 1), a1 + hstep, voffA);
            PG8_WAIT_L(8); PG8_BAR; PG8_WAIT_L(0); PG8_MMA(0, 0, At, B0); PG8_BAR; PG8_SCHED;
            PG8_LDB(B1, 0, 1); PG8_STAGE(PG8_SB(0, 0), b2, voffB);
            PG8_BAR; PG8_WAIT_L(0); PG8_MMA(0, 1, At, B1); PG8_BAR;
            PG8_LDA(At, 0, 1); PG8_STAGE(PG8_SA(0, 0), a2, voffA);
            PG8_BAR; PG8_WAIT_L(0); PG8_MMA(1, 0, At, B0); PG8_BAR; PG8_SCHED;
            PG8_STAGE(PG8_SB(0, 1), b2 + hstep, voffB);
            PG8_WAIT_V(6); PG8_BAR; PG8_MMA(1, 1, At, B1); PG8_BAR;
            PG8_LDB(B0, 1, 0); PG8_SCHED; PG8_LDA(At, 1, 0); PG8_STAGE(PG8_SA(0, 1), a2 + hstep, voffA);
            PG8_WAIT_L(8); PG8_BAR; PG8_WAIT_L(0); PG8_MMA(0, 0, At, B0); PG8_BAR; PG8_SCHED;
            PG8_LDB(B1, 1, 1); PG8_STAGE(PG8_SB(1, 0), b3, voffB);
            PG8_BAR; PG8_WAIT_L(0); PG8_MMA(0, 1, At, B1); PG8_BAR;
            PG8_LDA(At, 1, 1); PG8_STAGE(PG8_SA(1, 0), a3, voffA);
            PG8_BAR; PG8_WAIT_L(0); PG8_MMA(1, 0, At, B0); PG8_BAR; PG8_SCHED;
            PG8_STAGE(PG8_SB(1, 1), b3 + hstep, voffB);
            PG8_WAIT_V(6); PG8_BAR; PG8_MMA(1, 1, At, B1); PG8_BAR;
        }
        PG8_STAMP();
        if constexpr (!Epi::AFTER_DRAIN) { E(acc, cur, wr, wc, fr, fq); S.done(cur); }
        PG8_STAMP();
        if (!has_next) break;
#pragma unroll
        for (int a = 0; a < 2; ++a)
#pragma unroll
            for (int b = 0; b < 2; ++b)
#pragma unroll
                for (int m = 0; m < 4; ++m)
#pragma unroll
                    for (int n = 0; n < 2; ++n) acc[a][b][m][n] = (f32x4){0.f, 0.f, 0.f, 0.f};
        cur = nxt; cA = nA; cB = nB; ++ui;
    }
    PG8_WAIT_V(0);
    if (wr == 0) PG8_BAR;
    PG8_BAR;
    if constexpr (Epi::AFTER_DRAIN) { E.fused(acc, cur, wr, wc, fr, fq, lds, wid, lane); S.done(cur); }
    PG8_STAMP();
    if (STAMP && wid == 0) { stamps[lane] = lane < nts ? (((unsigned long long)(unsigned)ts_hi << 32) | (unsigned)ts_lo) : 0ull;
        if (lane == 62) stamps[62] = rt_entry; if (lane == 63) stamps[63] = (unsigned long long)wall_clock64(); }
#undef PG8_STAMP
#undef PG8_SA
#undef PG8_SB
#undef PG8_STAGE
#undef PG8_LDA
#undef PG8_LDB
#undef PG8_MMA
#undef PG8_WAIT_V
#undef PG8_WAIT_L
#undef PG8_BAR
#undef PG8_SCHED
}
}
#define LAS __attribute__((address_space(3)))
typedef unsigned short bf16_t;
using pg8::bf16x8; using pg8::f32x4; using pg8::u32x4;
typedef unsigned u32x2 __attribute__((ext_vector_type(2)));
#define MFMA16(a, b, c) __builtin_amdgcn_mfma_f32_16x16x32_bf16(a, b, c, 0, 0, 0)
#define LDS_WAIT() asm volatile("s_waitcnt lgkmcnt(0)" ::: "memory")

constexpr int T = 16384, S = 8192, D = 2048, NINP = 4096, PLD = 4160, NIN = 3864, DFF = 5632;
constexpr int C_LRUY = 1024, C_Q = 2048, C_KC = 2560, C_VC = 2688, C_KS = 2816, C_VS = 2944, C_KW = 3072, C_VW = 3200, C_GATE = 3328, C_MQ = 3352;
constexpr size_t MiB = (size_t)1 << 20, KiB = 1024;
constexpr size_t WS_WIN = 2 * MiB, WS_WOUT = 18 * MiB, WS_WUP = 26 * MiB, WS_WDOWN = 70 * MiB, WS_WMEM = 92 * MiB, WS_MEMB = 96 * MiB;
constexpr size_t WS_WAT = 98 * MiB, WS_WXT = WS_WAT + 256 * KiB, WS_W1K = WS_WAT + 512 * KiB, WS_W1V = WS_WAT + 768 * KiB, WS_W2K = WS_WAT + 1024 * KiB, WS_W2V = WS_WAT + 1032 * KiB;
constexpr size_t WS_MK = 100 * MiB, WS_MVT = WS_MK + 512 * KiB, WS_KCMP = 101 * MiB, WS_VCMPT = WS_KCMP + 256 * KiB, WS_AGG = 102 * MiB;
constexpr size_t WS_VST = 104 * MiB, WS_VWT = 108 * MiB, WS_KSC = 112 * MiB, WS_KWC = 116 * MiB, WS_H0F = 120 * MiB, WS_H0B = 248 * MiB, WS_P = 312 * MiB, WS_CAT = 442 * MiB, WS_END = 510 * MiB;
constexpr size_t WS_H1B = WS_H0B, WS_ACT = WS_P, WS_STAT0 = 1 * MiB, WS_STAT1 = 1 * MiB + 256 * KiB, WS_KS8 = 506 * MiB, WS_VS8 = 508 * MiB, WS_LA = 120 * MiB, WS_LU = 184 * MiB, WS_MIX = 120 * MiB, WS_FFN = 184 * MiB;
constexpr int LDS_BYTES = 147456, EX_OFF = 131072;
constexpr float ALPHA = 1.189207115002721f, LN_EPS = 1e-5f;

struct Args { const float* in[28]; float* out; unsigned char* ws; int ph_lo, ph_hi; };
struct Ctx {
    const float *x, *mem, *ln_in_g, *ln_in_b, *w_in, *lru_cw, *lru_cb, *lru_wa, *lru_ba, *lru_wx, *lru_bx, *lru_lam, *pe_k, *w1k, *w2k, *pe_v, *w1v, *w2v, *w_mem, *w_out, *ln1_g, *ln1_b, *w_up, *fcw, *fcb, *w_down, *ln2_g, *ln2_b;
    float* out; float2* AGG; float2* STAT0; float2* STAT1; unsigned char* Ks8; unsigned char* Vs8; float* LA; float* LU; bf16_t* MIX; bf16_t* FFN;
    bf16_t *WinT, *WoutT, *WupT, *WdownT, *WmemT, *MEMB, *WaT, *WxT, *W1kT, *W1vT, *W2kT, *W2vT, *MK, *MVT, *KCMP, *VCMPT, *VsT, *VwT, *KsC, *KwC, *H0B, *P, *CAT, *H1B, *ACT;
};

__device__ __forceinline__ float bf2f(unsigned short b) { return __uint_as_float((unsigned)b << 16); }
__device__ __forceinline__ unsigned pkbf(float lo, float hi) { return pg8::cvt_pk_bf16(lo, hi); }
__device__ __forceinline__ bf16_t f2bf1(float v) { return (bf16_t)(pkbf(v, 0.f) & 0xffffu); }
__device__ __forceinline__ bf16x8 ld8(const bf16_t* p) { return __builtin_bit_cast(bf16x8, *(const u32x4*)p); }
__device__ __forceinline__ bf16x8 pack8(const f32x4 a, const f32x4 b) { u32x4 w; w.x = pkbf(a[0], a[1]); w.y = pkbf(a[2], a[3]); w.z = pkbf(b[0], b[1]); w.w = pkbf(b[2], b[3]); return __builtin_bit_cast(bf16x8, w); }
__device__ __forceinline__ bf16x8 join8(const u32x2 a, const u32x2 b) { u32x4 w; w.x = a.x; w.y = a.y; w.z = b.x; w.w = b.y; return __builtin_bit_cast(bf16x8, w); }
__device__ __forceinline__ bf16x8 scale8(const bf16x8 v, float s) { const u32x4 w = __builtin_bit_cast(u32x4, v); u32x4 o;
    o.x = pkbf(__uint_as_float(w.x << 16) * s, __uint_as_float(w.x & 0xffff0000u) * s); o.y = pkbf(__uint_as_float(w.y << 16) * s, __uint_as_float(w.y & 0xffff0000u) * s);
    o.z = pkbf(__uint_as_float(w.z << 16) * s, __uint_as_float(w.z & 0xffff0000u) * s); o.w = pkbf(__uint_as_float(w.w << 16) * s, __uint_as_float(w.w & 0xffff0000u) * s); return __builtin_bit_cast(bf16x8, o); }
__device__ __forceinline__ float wave_sum(float v) {
#pragma unroll
    for (int o = 1; o < 64; o <<= 1) v += __shfl_xor(v, o);
    return v; }
__device__ __forceinline__ float sigmoidf_(float x) { return __builtin_amdgcn_rcpf(1.0f + __expf(-x)); }
__device__ __forceinline__ float rdlane(float v, int l) { return __builtin_bit_cast(float, __builtin_amdgcn_readlane(__builtin_bit_cast(int, v), l)); }
using pg8::gelu_tanh;
#define MFMA8(a, b, c) __builtin_amdgcn_mfma_f32_16x16x32_fp8_fp8(a, b, c, 0, 0, 0)
__device__ __forceinline__ unsigned pk4fp8(float f0, float f1, float f2, float f3) { int w = __builtin_amdgcn_cvt_pk_fp8_f32(f0, f1, 0, false); w = __builtin_amdgcn_cvt_pk_fp8_f32(f2, f3, w, true); return (unsigned)w; }
__device__ __forceinline__ long mk64(unsigned lo, unsigned hi) { return (long)(((unsigned long long)hi << 32) | (unsigned long long)lo); }

#define XB_TMO      128
#define XB_XCNT(j)  (256  + 64 * (j))
#define XB_XSUB(j)  (1280 + 64 * (j))
#define XB_XGEN(j)  (2304 + 64 * (j))
#define XB_TOP      3328
#define XB_TOPGEN   3392
#define XCD_BAR_WORDS 3456
#define XB_SPIN_CAP (1u << 18)

__device__ __forceinline__ unsigned xb_ld(unsigned* p)              { return __hip_atomic_load(p, __ATOMIC_RELAXED, __HIP_MEMORY_SCOPE_AGENT); }
__device__ __forceinline__ unsigned xb_add(unsigned* p, unsigned v) { return __hip_atomic_fetch_add(p, v, __ATOMIC_RELAXED, __HIP_MEMORY_SCOPE_AGENT); }
__device__ __forceinline__ unsigned xb_xcc_id() { return (unsigned)__builtin_amdgcn_s_getreg((3 << 11) | 20) & 0xFu; }
#define XB_SPIN(cond, bar) do { unsigned _sp = 0; while (cond) { __builtin_amdgcn_s_sleep(1); \
    if ((++_sp & 255u) == 0u) { if (xb_ld(&(bar)[XB_TMO])) break; if (_sp > XB_SPIN_CAP) { atomicAdd(&(bar)[XB_TMO], 1u); break; } } } } while (0)

struct XcdBarrier {
    unsigned* bar; unsigned x;
    volatile LAS unsigned* st;
};

__device__ __forceinline__ XcdBarrier xcd_barrier_post(unsigned* bar, volatile LAS unsigned* st) {
    XcdBarrier b; b.bar = bar; b.x = xb_xcc_id(); b.st = st;
    if (threadIdx.x == 0) (void)xb_add(&bar[XB_XCNT(b.x)], 1u);
    return b;
}
__device__ __forceinline__ void xcd_barrier_complete(unsigned* bar, unsigned x, unsigned& nloc, unsigned& nx) {
    const unsigned G = gridDim.x * gridDim.y * gridDim.z;
    unsigned sum, cnt, mine, sp = 0u;
    for (;;) {
        sum = 0u; cnt = 0u; mine = 0u;
#pragma unroll
        for (unsigned j = 0; j < 16; ++j) { const unsigned c = xb_ld(&bar[XB_XCNT(j)]); sum += c; cnt += (c > 0u) ? 1u : 0u; mine = (j == x) ? c : mine; }
        if (sum == G) break;
        __builtin_amdgcn_s_sleep(1);
        if ((++sp & 255u) == 0u) { if (xb_ld(&bar[XB_TMO])) break; if (sp > XB_SPIN_CAP) { atomicAdd(&bar[XB_TMO], 1u); break; } }
    }
    nloc = mine > 0u ? mine : 1u; nx = cnt > 0u ? cnt : 1u;
}

__device__ __forceinline__ void xcd_barrier(const XcdBarrier& b) {
    asm volatile("s_waitcnt vmcnt(0)" ::: "memory");
    __syncthreads();
    if (threadIdx.x == 0) {
        unsigned* bar = b.bar;
        __builtin_amdgcn_s_waitcnt(0);
        unsigned nloc = b.st[0], nx = b.st[1];
        if (nloc == 0u) { xcd_barrier_complete(bar, b.x, nloc, nx); b.st[0] = nloc; b.st[1] = nx; }
        const unsigned old = xb_add(&bar[XB_XSUB(b.x)], 1u);
        const unsigned gen = old / nloc;
        if (old + 1u == (gen + 1u) * nloc) {
            __builtin_amdgcn_fence(__ATOMIC_RELEASE, "agent");
            asm volatile("s_waitcnt vmcnt(0)" ::: "memory");
            const unsigned og = xb_add(&bar[XB_TOP], 1u);
            const unsigned tg = og / nx;
            if (og + 1u == (tg + 1u) * nx) xb_add(&bar[XB_TOPGEN], 1u);
            else XB_SPIN(xb_ld(&bar[XB_TOPGEN]) == tg, bar);
            __builtin_amdgcn_fence(__ATOMIC_ACQUIRE, "agent");
            xb_add(&bar[XB_XGEN(b.x)], 1u);
            asm volatile("s_waitcnt vmcnt(0)" ::: "memory");
        } else {
            XB_SPIN(xb_ld(&bar[XB_XGEN(b.x)]) == gen, bar);
            __builtin_amdgcn_fence(__ATOMIC_ACQUIRE, "agent");
            asm volatile("s_waitcnt vmcnt(0)" ::: "memory");
        }
    }
    __syncthreads();
}

template <int MODE>
__device__ __forceinline__ void transpose_item(const float* W, int K, int N, bf16_t* WT, LAS float* scr, int item, int nblk, int lane, int ldw = 0) {
    if (ldw == 0) ldw = K;
    const int kb = item / nblk, nb = item % nblk, k0 = 64 * kb, n0 = 64 * nb, nn = n0 + lane;
#pragma unroll 1
    for (int h = 0; h < 2; ++h) { float tv[32];
#pragma unroll
        for (int i = 0; i < 32; ++i) tv[i] = (nn < N) ? W[(size_t)(k0 + 32 * h + i) * N + nn] : 0.f;
#pragma unroll
        for (int i = 0; i < 32; ++i) scr[(32 * h + i) * 65 + lane] = tv[i]; }
    LDS_WAIT();
    const int c = lane & 7;
#pragma unroll
    for (int j = 0; j < 8; ++j) { const int n = (lane >> 3) + 8 * j; const LAS float* s = scr + (8 * c) * 65 + n;
        u32x4 o; o.x = pkbf(s[0], s[65]); o.y = pkbf(s[130], s[195]); o.z = pkbf(s[260], s[325]); o.w = pkbf(s[390], s[455]);
        int row = n0 + n;
        if (MODE == 1) { const int bj = row / 5632, rem = row % 5632; row = 256 * (rem / 128) + 128 * bj + (rem % 128); }
        if (MODE == 2) { const int kk8 = k0 + 8 * c; *(u32x4*)(WT + ((size_t)(row >> 4) * (K >> 5) + (kk8 >> 5)) * 512 + ((((kk8 & 31) >> 3) * 16 + (row & 15)) * 8)) = o; }
        else *(u32x4*)(WT + (size_t)row * ldw + k0 + 8 * c) = o; }
    LDS_WAIT();
}
template <int NR>
__device__ __forceinline__ void ln_rows(const float* xbase, const float* g, const float* bt, float* ofbase, bf16_t* obbase, float2* st, int m0, int mstride, int lane) {
    f32x4 v[NR][8]; float s[NR], s2[NR], mean[NR], rstd[NR];
#pragma unroll
    for (int i = 0; i < NR; ++i) { const int m = (m0 + i * mstride < T) ? m0 + i * mstride : T - 1; s[i] = 0.f;
#pragma unroll
        for (int j = 0; j < 8; ++j) v[i][j] = ((const f32x4*)(xbase + (size_t)m * D))[lane + 64 * j]; }
#pragma unroll
    for (int i = 0; i < NR; ++i)
#pragma unroll
        for (int j = 0; j < 8; ++j) s[i] += (v[i][j][0] + v[i][j][1]) + (v[i][j][2] + v[i][j][3]);
#pragma unroll
    for (int o = 1; o < 64; o <<= 1)
#pragma unroll
        for (int i = 0; i < NR; ++i) s[i] += __shfl_xor(s[i], o);
#pragma unroll
    for (int i = 0; i < NR; ++i) { mean[i] = s[i] * (1.f / 2048.f); s2[i] = 0.f;
#pragma unroll
        for (int j = 0; j < 8; ++j) { v[i][j] = v[i][j] - mean[i]; s2[i] += (v[i][j][0] * v[i][j][0] + v[i][j][1] * v[i][j][1]) + (v[i][j][2] * v[i][j][2] + v[i][j][3] * v[i][j][3]); } }
#pragma unroll
    for (int o = 1; o < 64; o <<= 1)
#pragma unroll
        for (int i = 0; i < NR; ++i) s2[i] += __shfl_xor(s2[i], o);
#pragma unroll
    for (int i = 0; i < NR; ++i) rstd[i] = 1.0f / sqrtf(s2[i] * (1.f / 2048.f) + LN_EPS);
#pragma unroll
    for (int j = 0; j < 8; ++j) { const f32x4 gg = ((const f32x4*)g)[lane + 64 * j], bb = ((const f32x4*)bt)[lane + 64 * j];
#pragma unroll
        for (int i = 0; i < NR; ++i) { const int m = m0 + i * mstride; if (m < T) { const f32x4 y = v[i][j] * rstd[i] * gg + bb;
            if (ofbase) ((f32x4*)(ofbase + (size_t)m * D))[lane + 64 * j] = y;
            if (obbase) { u32x2 w; w.x = pkbf(y[0], y[1]); w.y = pkbf(y[2], y[3]); ((u32x2*)(obbase + (size_t)m * D))[lane + 64 * j] = w; } } } }
    if (st && lane == 0) {
#pragma unroll
        for (int i = 0; i < NR; ++i) { const int m = m0 + i * mstride; if (m < T) st[m] = make_float2(mean[i], rstd[i]); } }
}
template <int NR>
__device__ __forceinline__ void ln_fuse_rows(const float* xbase, const float2* sta, const float* ga, const float* ba, const bf16_t* addbase, float* ybase, const float* gb, const float* bb,
                                             float* ofbase, bf16_t* obbase, float2* stb, int m0, int mstride, int lane) {
    f32x4 v[NR][8]; float s[NR], s2[NR], mean[NR], rstd[NR];
#pragma unroll
    for (int i = 0; i < NR; ++i) { const int m = (m0 + i * mstride < T) ? m0 + i * mstride : T - 1; const float2 st = sta[m]; s[i] = 0.f;
#pragma unroll
        for (int j = 0; j < 8; ++j) { const f32x4 x = ((const f32x4*)(xbase + (size_t)m * D))[lane + 64 * j]; const u32x2 aw = ((const u32x2*)(addbase + (size_t)m * D))[lane + 64 * j];
            const f32x4 g4 = ((const f32x4*)ga)[lane + 64 * j], b4 = ((const f32x4*)ba)[lane + 64 * j];
            const f32x4 ad = (f32x4){__uint_as_float(aw.x << 16), __uint_as_float(aw.x & 0xffff0000u), __uint_as_float(aw.y << 16), __uint_as_float(aw.y & 0xffff0000u)};
            v[i][j] = (((x - st.x) * st.y) * g4 + b4) * ALPHA + ad; } }
    if (ybase) {
#pragma unroll
        for (int i = 0; i < NR; ++i) { const int m = m0 + i * mstride; if (m < T) {
#pragma unroll
            for (int j = 0; j < 8; ++j) ((f32x4*)(ybase + (size_t)m * D))[lane + 64 * j] = v[i][j]; } } }
#pragma unroll
    for (int i = 0; i < NR; ++i)
#pragma unroll
        for (int j = 0; j < 8; ++j) s[i] += (v[i][j][0] + v[i][j][1]) + (v[i][j][2] + v[i][j][3]);
#pragma unroll
    for (int o = 1; o < 64; o <<= 1)
#pragma unroll
        for (int i = 0; i < NR; ++i) s[i] += __shfl_xor(s[i], o);
#pragma unroll
    for (int i = 0; i < NR; ++i) { mean[i] = s[i] * (1.f / 2048.f); s2[i] = 0.f;
#pragma unroll
        for (int j = 0; j < 8; ++j) { v[i][j] = v[i][j] - mean[i]; s2[i] += (v[i][j][0] * v[i][j][0] + v[i][j][1] * v[i][j][1]) + (v[i][j][2] * v[i][j][2] + v[i][j][3] * v[i][j][3]); } }
#pragma unroll
    for (int o = 1; o < 64; o <<= 1)
#pragma unroll
        for (int i = 0; i < NR; ++i) s2[i] += __shfl_xor(s2[i], o);
#pragma unroll
    for (int i = 0; i < NR; ++i) rstd[i] = 1.0f / sqrtf(s2[i] * (1.f / 2048.f) + LN_EPS);
#pragma unroll
    for (int j = 0; j < 8; ++j) { const f32x4 gg = ((const f32x4*)gb)[lane + 64 * j], bq = ((const f32x4*)bb)[lane + 64 * j];
#pragma unroll
        for (int i = 0; i < NR; ++i) { const int m = m0 + i * mstride; if (m < T) { const f32x4 y = v[i][j] * rstd[i] * gg + bq;
            if (ofbase) ((f32x4*)(ofbase + (size_t)m * D))[lane + 64 * j] = y;
            if (obbase) { u32x2 w; w.x = pkbf(y[0], y[1]); w.y = pkbf(y[2], y[3]); ((u32x2*)(obbase + (size_t)m * D))[lane + 64 * j] = w; } } } }
    if (stb && lane == 0) {
#pragma unroll
        for (int i = 0; i < NR; ++i) { const int m = m0 + i * mstride; if (m < T) stb[m] = make_float2(mean[i], rstd[i]); } }
}
__device__ __forceinline__ void phase0(const Ctx& c, LAS unsigned char* lds, int gw, int NGW, int wave, int lane) {
    LAS float* scr = (LAS float*)(lds + wave * 16640);
    constexpr int I0 = 32 * 64, I1 = 32 * 32, I2 = 32 * 176, I4 = 32 * 16, I5 = 32, I6 = 32, I7 = 32, I8 = 32, I9 = 1, I10 = 1;
    constexpr int NIT = I0 + I1 + I2 + I4 + I5 + I6 + I7 + I8 + I9 + I10;
    for (int it = gw; it < NIT; it += NGW) {
        int r = it;
        if (r < I0) { transpose_item<0>(c.w_in, 2048, NIN, c.WinT, scr, r, 64, lane); continue; } r -= I0;
        if (r < I1) { transpose_item<0>(c.w_out, 2048, 2048, c.WoutT, scr, r, 32, lane); continue; } r -= I1;
        if (r < I2) { transpose_item<1>(c.w_up, 2048, 11264, c.WupT, scr, r, 176, lane); continue; } r -= I2;
        if (r < I4) { transpose_item<2>(c.w_mem, 2048, 1024, c.WmemT, scr, r, 16, lane); continue; } r -= I4;
        if (r < I5) { transpose_item<2>(c.lru_wa + (r >> 2) * 16384, 128, 128, c.WaT + (r >> 2) * 16384, scr, r & 3, 2, lane); continue; } r -= I5;
        if (r < I6) { transpose_item<2>(c.lru_wx + (r >> 2) * 16384, 128, 128, c.WxT + (r >> 2) * 16384, scr, r & 3, 2, lane); continue; } r -= I6;
        if (r < I7) { transpose_item<2>(c.w1k, 2048, 64, c.W1kT, scr, r, 1, lane); continue; } r -= I7;
        if (r < I8) { transpose_item<2>(c.w1v, 2048, 64, c.W1vT, scr, r, 1, lane); continue; } r -= I8;
        if (r < I9) { transpose_item<0>(c.w2k, 64, 64, c.W2kT, scr, r, 1, lane); continue; } r -= I9;
        transpose_item<0>(c.w2v, 64, 64, c.W2vT, scr, r, 1, lane);
    }
    for (int m = gw; m < T; m += 2 * NGW) ln_rows<2>(c.x, c.ln_in_g, c.ln_in_b, nullptr, c.H0B, c.STAT0, m, NGW, lane);
    for (int i = gw * 64 + lane; i < 512 * 2048 / 4; i += NGW * 64) { const f32x4 v = ((const f32x4*)c.mem)[i]; u32x2 w; w.x = pkbf(v[0], v[1]); w.y = pkbf(v[2], v[3]); const int m = i >> 9, k = (i & 511) * 4;
        *(u32x2*)(c.MEMB + ((size_t)(m >> 4) * 64 + (k >> 5)) * 512 + ((((k & 31) >> 3) * 16 + (m & 15)) * 8) + (k & 7)) = w; }
}
__device__ __forceinline__ void lru_walk1(const Ctx& c, LAS unsigned char* lds, int tp0, int tid) {
    asm volatile("" : "+v"(tid));
    const int ck0 = tp0 & 127, n = (tp0 >> 7) & 7, b = tp0 >> 10, lane = tid & 63, w = tid >> 6;
    LAS float* XC = (LAS float*)lds; LAS bf16_t* XB = (LAS bf16_t*)(lds + 32768);
    const int ch = tid & 127, sg = tid >> 7, chg = n * 128 + ch;
    const float w0 = c.lru_cw[chg], w1 = c.lru_cw[1024 + chg], w2 = c.lru_cw[2048 + chg], w3 = c.lru_cw[3072 + chg], cb = c.lru_cb[chg];
    const bf16_t* xp = c.P + (size_t)b * S * PLD + chg;
    const int r = lane & 15, q = lane >> 4, chl = 16 * w + r, cg2 = n * 128 + chl;
    const float bav = c.lru_ba[cg2], bxv = c.lru_bx[cg2], sp = log1pf(expf(-c.lru_lam[cg2]));
    float xr[19];
#define LRU_LOAD(CK) do { const int tt0_ = (CK) * 64 + sg * 16 - 3; _Pragma("unroll") for (int i = 0; i < 19; ++i) xr[i] = (tt0_ + i >= 0) ? bf2f(xp[(size_t)(tt0_ + i) * PLD]) : 0.f; } while (0)
    LRU_LOAD(ck0);
#pragma unroll 1
    for (int it = 0; it < 8; ++it) { const int ck = ck0 + it; const size_t row0 = (size_t)b * S + ck * 64;
        bf16x8 wa[4], wx[4];
#pragma unroll
        for (int ks = 0; ks < 4; ++ks) { const size_t wo = (size_t)n * 16384 + (size_t)((w * 4 + ks) * 64 + lane) * 8; wa[ks] = ld8(c.WaT + wo); wx[ks] = ld8(c.WxT + wo); }
        { const int tl0 = sg * 16;
#pragma unroll
          for (int i = 0; i < 16; ++i) { const float xc = cb + w0 * xr[i] + w1 * xr[i + 1] + w2 * xr[i + 2] + w3 * xr[i + 3]; XC[(tl0 + i) * 128 + ch] = xc; XB[(tl0 + i) * 136 + ch] = f2bf1(xc); } }
        if (it < 7) LRU_LOAD(ck + 1);
        __syncthreads();
        f32x4 ga[4], gx[4];
#pragma unroll
        for (int i = 0; i < 4; ++i) { ga[i] = (f32x4){0.f, 0.f, 0.f, 0.f}; gx[i] = ga[i]; }
#pragma unroll
        for (int ks = 0; ks < 4; ++ks)
#pragma unroll
            for (int rt = 0; rt < 4; ++rt) { const bf16x8 a = *(const LAS bf16x8*)(XB + (16 * rt + r) * 136 + 32 * ks + 8 * q); ga[rt] = MFMA16(a, wa[ks], ga[rt]); gx[rt] = MFMA16(a, wx[ks], gx[rt]); }
        float At = 1.f, Ht = 0.f;
#pragma unroll
        for (int rt = 0; rt < 4; ++rt) { float Al = 1.f, Hl = 0.f;
#pragma unroll
            for (int j = 0; j < 4; ++j) { const int t = 16 * rt + 4 * q + j; const float da = 1.0f + __expf(fminf(-(ga[rt][j] + bav), 80.0f)), dx = 1.0f + __expf(fminf(-(gx[rt][j] + bxv), 80.0f)), rc = __builtin_amdgcn_rcpf(da * dx);
                const float rr = rc * dx, ii = rc * da, la = -8.0f * rr * sp, x2 = 2.0f * la;
                float em = -x2 * (1.0f + x2 * (0.5f + x2 * (0.16666667f + x2 * (0.041666668f + x2 * 0.0083333338f))));
                if (__ballot(x2 <= -0.25f) != 0ull) em = (x2 > -0.25f) ? em : 1.0f - __expf(x2);
                const float av = __expf(la), uv = __builtin_amdgcn_sqrtf(em) * ii * XC[t * 128 + chl];
                c.LA[(row0 + t) * 1024 + cg2] = av; c.LU[(row0 + t) * 1024 + cg2] = uv; Hl = av * Hl + uv; Al *= av; }
            { const float Ap = __shfl_xor(Al, 16), Hp = __shfl_xor(Hl, 16); if (q & 1) { Hl = Hp * Al + Hl; Al = Ap * Al; } }
            { const float Ap = __shfl_xor(Al, 32), Hp = __shfl_xor(Hl, 32); if (q & 2) { Hl = Hp * Al + Hl; Al = Ap * Al; } }
            Ht = Ht * Al + Hl; At *= Al; }
        if (q == 3) c.AGG[((size_t)b * 128 + ck) * 1024 + cg2] = make_float2(At, Ht);
        __syncthreads();
    }
#undef LRU_LOAD
}
__device__ __forceinline__ void lru_walk2(const Ctx& c, LAS unsigned char* lds, int tp0, int tid) {
    asm volatile("" : "+v"(tid));
    const int ck0 = tp0 & 127, n = (tp0 >> 7) & 7, b = tp0 >> 10, ch = tid & 127, sg = tid >> 7, chg = n * 128 + ch;
    LAS float* SEG = (LAS float*)(lds + 116736); LAS float* SEG2 = (LAS float*)(lds + 120832); LAS float* CAR = (LAS float*)(lds + 124928);
    float av[16], uv[16], yv[16];
#define LRU2_LOAD(CK) do { const size_t r0_ = (size_t)b * S + (CK) * 64 + sg * 16; _Pragma("unroll") for (int i = 0; i < 16; ++i) { av[i] = c.LA[(r0_ + i) * 1024 + chg]; uv[i] = c.LU[(r0_ + i) * 1024 + chg]; \
            yv[i] = bf2f(c.P[(r0_ + i) * PLD + C_LRUY + chg]); } } while (0)
    LRU2_LOAD(ck0);
#pragma unroll 1
    for (int it = 0; it < 8; ++it) { const int ck = ck0 + it; const size_t row0 = (size_t)b * S + ck * 64 + sg * 16;
        float A = 1.f, H = 0.f;
#pragma unroll
        for (int i = 0; i < 16; ++i) { H = av[i] * H + uv[i]; A *= av[i]; }
        SEG[(sg * 128 + ch) * 2] = A; SEG[(sg * 128 + ch) * 2 + 1] = H;
        if (it == 0) { float CA = 1.f, CH = 0.f; const int per = (ck + 3) >> 2, lo = sg * per, hi = (lo + per < ck) ? lo + per : ck;
#pragma unroll 8
            for (int cc = lo; cc < hi; ++cc) { const float2 v = c.AGG[((size_t)b * 128 + cc) * 1024 + chg]; CH = v.x * CH + v.y; CA *= v.x; }
            SEG2[(sg * 128 + ch) * 2] = CA; SEG2[(sg * 128 + ch) * 2 + 1] = CH; }
        __syncthreads();
        float Hc = 0.f;
        if (it == 0) {
#pragma unroll
            for (int s = 0; s < 4; ++s) Hc = SEG2[(s * 128 + ch) * 2] * Hc + SEG2[(s * 128 + ch) * 2 + 1]; }
        else Hc = CAR[ch];
        for (int s = 0; s < sg; ++s) Hc = SEG[(s * 128 + ch) * 2] * Hc + SEG[(s * 128 + ch) * 2 + 1];
        float ov[16];
#pragma unroll
        for (int i = 0; i < 16; ++i) { Hc = av[i] * Hc + uv[i]; ov[i] = gelu_tanh(yv[i]) * Hc; }
        if (it < 7) LRU2_LOAD(ck + 1);
#pragma unroll
        for (int i = 0; i < 16; ++i) c.CAT[(row0 + i) * D + chg] = f2bf1(ov[i]);
        __syncthreads();
        if (sg == 3) CAR[ch] = Hc;
    }
    __syncthreads();
#undef LRU2_LOAD
}
__device__ __forceinline__ void vt_tile(const Ctx& c, LAS unsigned char* lds, int bt, int tid) {
    LAS bf16_t* TL = (LAS bf16_t*)lds;
    const size_t tok0 = (size_t)bt * 64; const int b = bt >> 7, blk = bt & 127;
#pragma unroll
    for (int i = 0; i < 8; ++i) { const int cidx = tid + 512 * i, row = cidx >> 6, chn = cidx & 63; *(LAS u32x4*)(TL + row * 520 + chn * 8) = *(const u32x4*)(c.P + (tok0 + row) * PLD + C_KS + chn * 8); }
    __syncthreads();
#pragma unroll
    for (int i = 2; i < 4; ++i) { const int cid = tid + 512 * i, ln = cid & 63, f = (cid >> 6) & 7, gg = (cid >> 9) & 1, arr = cid >> 10, r = ln & 15, q = ln >> 4;
        const size_t blkoff = ((size_t)(b * 2 + gg) * 128 + blk) * 4096 + (size_t)(f * 64 + ln) * 8;
        { const int k4 = f >> 1, ks2 = f & 1; *(u32x4*)((arr ? c.KwC : c.KsC) + blkoff) = *(const LAS u32x4*)(TL + (16 * k4 + r) * 520 + arr * 256 + 64 * gg + 32 * ks2 + 8 * q); }
        { const int kp2 = f >> 2, dt = f & 3, col = 128 + arr * 256 + 64 * gg + 16 * dt + r; unsigned v[8];
#pragma unroll
          for (int e = 0; e < 8; ++e) v[e] = TL[(32 * kp2 + 16 * (e >> 2) + 4 * q + (e & 3)) * 520 + col];
          u32x4 o; o.x = v[0] | (v[1] << 16); o.y = v[2] | (v[3] << 16); o.z = v[4] | (v[5] << 16); o.w = v[6] | (v[7] << 16); *(u32x4*)((arr ? c.VwT : c.VsT) + blkoff) = o; } }
    { const int ln = tid & 63, r = ln & 15, q = ln >> 4, f2 = (tid >> 6) & 3, gg = tid >> 8; const size_t bo = ((size_t)(b * 2 + gg) * 128 + blk) * 4096 + (size_t)(f2 * 64 + ln) * 16;
      { const LAS bf16_t* src = TL + (16 * f2 + r) * 520 + 64 * gg + 8 * q; u32x4 o;
        o.x = pk4fp8(bf2f(src[0]), bf2f(src[1]), bf2f(src[2]), bf2f(src[3])); o.y = pk4fp8(bf2f(src[4]), bf2f(src[5]), bf2f(src[6]), bf2f(src[7]));
        o.z = pk4fp8(bf2f(src[32]), bf2f(src[33]), bf2f(src[34]), bf2f(src[35])); o.w = pk4fp8(bf2f(src[36]), bf2f(src[37]), bf2f(src[38]), bf2f(src[39])); *(u32x4*)(c.Ks8 + bo) = o; }
      { const int kp2 = f2 >> 1, dtp = f2 & 1; unsigned wv[4];
#pragma unroll
        for (int hf = 0; hf < 2; ++hf) { const int col = 128 + 64 * gg + 16 * (2 * dtp + hf) + r; const LAS bf16_t* s0 = TL + (32 * kp2 + 4 * q) * 520 + col; const LAS bf16_t* s1 = s0 + 16 * 520;
            wv[2 * hf] = pk4fp8(bf2f(s0[0]), bf2f(s0[520]), bf2f(s0[1040]), bf2f(s0[1560])); wv[2 * hf + 1] = pk4fp8(bf2f(s1[0]), bf2f(s1[520]), bf2f(s1[1040]), bf2f(s1[1560])); }
        u32x4 o; o.x = wv[0]; o.y = wv[1]; o.z = wv[2]; o.w = wv[3]; *(u32x4*)(c.Vs8 + bo) = o; } }
    __syncthreads();
}
__device__ __forceinline__ void compress_task(const Ctx& c, LAS unsigned char* lds, int task, int tid) {
    const int lane = tid & 63, w = tid >> 6;
    const int nb = task & 31, g = (task >> 5) & 1, b = (task >> 6) & 1, kv = task >> 7, r = lane & 15, q = lane >> 4;
    LAS float* PART = (LAS float*)lds; LAS bf16_t* hid = (LAS bf16_t*)(lds + 32768);
    int n = 16 * nb + r; if (n > 510) n = 510;
    const bf16_t* W1T = kv ? c.W1vT : c.W1kT; const bf16_t* W2T = kv ? c.W2vT : c.W2kT; const float* pe = kv ? c.pe_v : c.pe_k;
    const bf16_t* arow = c.P + ((size_t)b * S + 16 * n) * PLD + (kv ? C_VC : C_KC) + 64 * g;
    f32x4 acc[4];
#pragma unroll
    for (int i = 0; i < 4; ++i) acc[i] = (f32x4){0.f, 0.f, 0.f, 0.f};
#pragma unroll
    for (int k8 = 0; k8 < 8; ++k8) { const int ks = 8 * w + k8, l = ks >> 1, d0 = (ks & 1) * 32 + 8 * q;
        const u32x4 raw = *(const u32x4*)(arow + (size_t)l * PLD + d0); const f32x4 p0 = *(const f32x4*)(pe + l * 64 + d0), p1 = *(const f32x4*)(pe + l * 64 + d0 + 4);
        u32x4 o; o.x = pkbf(__uint_as_float(raw.x << 16) + p0[0], __uint_as_float(raw.x & 0xffff0000u) + p0[1]); o.y = pkbf(__uint_as_float(raw.y << 16) + p0[2], __uint_as_float(raw.y & 0xffff0000u) + p0[3]);
        o.z = pkbf(__uint_as_float(raw.z << 16) + p1[0], __uint_as_float(raw.z & 0xffff0000u) + p1[1]); o.w = pkbf(__uint_as_float(raw.w << 16) + p1[2], __uint_as_float(raw.w & 0xffff0000u) + p1[3]);
        const bf16x8 a = __builtin_bit_cast(bf16x8, o);
#pragma unroll
        for (int et = 0; et < 4; ++et) acc[et] = MFMA16(a, ld8(W1T + (size_t)((et * 64 + ks) * 64 + lane) * 8), acc[et]); }
#pragma unroll
    for (int et = 0; et < 4; ++et)
#pragma unroll
        for (int j = 0; j < 4; ++j) PART[(w * 16 + 4 * q + j) * 64 + 16 * et + r] = acc[et][j];
    __syncthreads();
    if (w == 0) {
#pragma unroll
        for (int et = 0; et < 4; ++et)
#pragma unroll
            for (int j = 0; j < 4; ++j) { float s = 0.f;
#pragma unroll
                for (int ww = 0; ww < 8; ++ww) s += PART[(ww * 16 + 4 * q + j) * 64 + 16 * et + r];
                hid[(4 * q + j) * 72 + 16 * et + r] = f2bf1(gelu_tanh(s)); }
        LDS_WAIT();
        f32x4 o2[4];
#pragma unroll
        for (int i = 0; i < 4; ++i) o2[i] = (f32x4){0.f, 0.f, 0.f, 0.f};
#pragma unroll
        for (int ks = 0; ks < 2; ++ks) { const bf16x8 a = *(const LAS bf16x8*)(hid + r * 72 + 32 * ks + 8 * q);
#pragma unroll
            for (int ft = 0; ft < 4; ++ft) o2[ft] = MFMA16(a, ld8(W2T + (16 * ft + r) * 64 + 32 * ks + 8 * q), o2[ft]); }
#pragma unroll
        for (int ft = 0; ft < 4; ++ft)
#pragma unroll
            for (int j = 0; j < 4; ++j) { const int nn = 16 * nb + 4 * q + j; const float val = nn < 511 ? o2[ft][j] : 0.f;
                const int f = 16 * ft + r;
                if (!kv) c.KCMP[(size_t)(b * 2 + g) * 32768 + ((((nn >> 4) * 2 + (f >> 5)) * 64 + ((f & 31) >> 3) * 16 + (nn & 15)) * 8) + (f & 7)] = f2bf1(val);
                else c.VCMPT[(size_t)(b * 2 + g) * 32768 + ((((nn >> 5) * 4 + ft) * 64 + ((nn & 15) >> 2) * 16 + r) * 8) + (nn & 3) + 4 * ((nn >> 4) & 1)] = f2bf1(val); } }
    __syncthreads();
}
__device__ __forceinline__ void memkv_task(const Ctx& c, int task, int lane) {
    const int rt = task >> 6, ct = task & 63, r = lane & 15, q = lane >> 4; f32x4 acc = (f32x4){0.f, 0.f, 0.f, 0.f};
    const bf16_t* ap = c.MEMB + (size_t)rt * 32768 + lane * 8; const bf16_t* bp = c.WmemT + (size_t)ct * 32768 + lane * 8;
#pragma unroll 8
    for (int ks = 0; ks < 64; ++ks) acc = MFMA16(ld8(ap + 512 * ks), ld8(bp + 512 * ks), acc);
#pragma unroll
    for (int j = 0; j < 4; ++j) { const int row = 16 * rt + 4 * q + j;
        const int bb = row >> 8, key = row & 255, col = (16 * ct + r) & 511, h = col >> 7, dd = col & 127;
        if (ct < 32) c.MK[(size_t)(bb * 4 + h) * 32768 + ((((key >> 4) * 4 + (dd >> 5)) * 64 + ((dd & 31) >> 3) * 16 + (key & 15)) * 8) + (dd & 7)] = f2bf1(acc[j]);
        else c.MVT[(size_t)(bb * 4 + h) * 32768 + ((((key >> 5) * 8 + (dd >> 4)) * 64 + ((key & 15) >> 2) * 16 + (dd & 15)) * 8) + (key & 3) + 4 * ((key >> 4) & 1)] = f2bf1(acc[j]); }
}
__device__ __forceinline__ void nsa_item(const Ctx& c, LAS unsigned char* wl, LAS unsigned char* sl, int item, int lane) {
    const int qt = item & 511, g = (item >> 9) & 1, b = item >> 10, r = lane & 15, q = lane >> 4, t0 = 16 * qt, cur = qt >> 2;
    const size_t rowb = (size_t)b * S; const bf16_t* Pb = c.P + rowb * PLD;
    LAS float* impA = (LAS float*)wl; LAS float* impB = impA + 2048; LAS float* OACC = (LAS float*)wl; LAS float* GL = (LAS float*)(sl + 320);
    const f32x4 z4 = (f32x4){0.f, 0.f, 0.f, 0.f};
#pragma unroll
    for (int i = 0; i < 16; ++i) ((LAS f32x4*)wl)[lane + 64 * i] = z4;
#pragma unroll
    for (int i = 0; i < 3; ++i) { const int idx = lane + 64 * i, qi = idx / 12, k = idx - qi * 12; GL[idx] = sigmoidf_(bf2f(Pb[(size_t)(t0 + qi) * PLD + C_GATE + 12 * g + k])); }
    bf16x8 qf[4][2];
#define LOAD_QF() do { _Pragma("unroll") for (int h = 0; h < 4; ++h) _Pragma("unroll") for (int ks = 0; ks < 2; ++ks) qf[h][ks] = scale8(ld8(Pb + (size_t)(t0 + r) * PLD + C_Q + (4 * g + h) * 64 + 32 * ks + 8 * q), 0.125f); } while (0)
    LOAD_QF();
    const int nkt = (qt + 15) >> 4; const bf16_t* Kc = c.KCMP + (size_t)(b * 2 + g) * 32768 + lane * 8; const bf16_t* Vc = c.VCMPT + (size_t)(b * 2 + g) * 32768 + lane * 8;
    float m[4], l[4];
#pragma unroll
    for (int h = 0; h < 4; ++h) { m[h] = -1e30f; l[h] = 0.f; }
    for (int kt = 0; kt < nkt; ++kt) { const bf16x8 k0 = ld8(Kc + kt * 1024), k1 = ld8(Kc + kt * 1024 + 512);
#pragma unroll
        for (int h = 0; h < 4; ++h) { f32x4 s = MFMA16(k0, qf[h][0], z4); s = MFMA16(k1, qf[h][1], s);
            if (16 * kt + 15 >= qt - 1) {
#pragma unroll
                for (int j = 0; j < 4; ++j) { const int nk = 16 * kt + 4 * q + j; if (!((nk < qt - 1) || (nk == qt - 1 && r == 15))) s[j] = -1e30f; } }
            const float tm = fmaxf(fmaxf(s[0], s[1]), fmaxf(s[2], s[3])), mn = fmaxf(m[h], tm); float ls = l[h] * __expf(m[h] - mn);
#pragma unroll
            for (int j = 0; j < 4; ++j) ls += s[j] > -1e29f ? __expf(s[j] - mn) : 0.f;
            l[h] = ls; m[h] = mn; } }
    float rl[4];
#pragma unroll
    for (int h = 0; h < 4; ++h) {
#pragma unroll
        for (int o = 16; o < 64; o <<= 1) { const float mo = __shfl_xor(m[h], o), lo = __shfl_xor(l[h], o), mn = fmaxf(m[h], mo); l[h] = l[h] * __expf(m[h] - mn) + lo * __expf(mo - mn); m[h] = mn; }
        rl[h] = l[h] > 0.f ? 1.0f / l[h] : 0.f; }
    f32x4 oc[4][4];
#pragma unroll
    for (int h = 0; h < 4; ++h)
#pragma unroll
        for (int dt = 0; dt < 4; ++dt) oc[h][dt] = z4;
    for (int kp = 0; kp < (nkt + 1) / 2; ++kp) { f32x4 pp[4][2];
#pragma unroll
        for (int hf = 0; hf < 2; ++hf) { const int kt = 2 * kp + hf;
            if (kt < nkt) { const bf16x8 k0 = ld8(Kc + kt * 1024), k1 = ld8(Kc + kt * 1024 + 512); f32x4 ps = z4;
#pragma unroll
                for (int h = 0; h < 4; ++h) { f32x4 s = MFMA16(k0, qf[h][0], z4); s = MFMA16(k1, qf[h][1], s);
#pragma unroll
                    for (int j = 0; j < 4; ++j) { const int nk = 16 * kt + 4 * q + j; const bool v = (16 * kt + 15 < qt - 1) || (nk < qt - 1) || (nk == qt - 1 && r == 15); s[j] = v ? __expf(s[j] - m[h]) * rl[h] : 0.f; }
                    pp[h][hf] = s; ps += s; }
                const int J = 4 * kt + q; impA[r * 128 + J] = (ps[0] + ps[1]) + (ps[2] + ps[3]); if (J + 1 < 128) impB[r * 128 + J + 1] = ps[3];
            } else {
#pragma unroll
                for (int h = 0; h < 4; ++h) pp[h][hf] = z4; } }
#pragma unroll
        for (int dt = 0; dt < 4; ++dt) { const bf16x8 vf = ld8(Vc + (kp * 4 + dt) * 512);
#pragma unroll
            for (int h = 0; h < 4; ++h) oc[h][dt] = MFMA16(pack8(pp[h][0], pp[h][1]), vf, oc[h][dt]); } }
    LDS_WAIT();
    LAS unsigned char* selL = (LAS unsigned char*)sl;
    if (cur < 16) { for (int qi = 0; qi < 16; ++qi) { if (lane <= cur) selL[qi * 16 + lane] = (unsigned char)lane; if (lane == 0) selL[256 + qi] = (unsigned char)(cur + 1); } }
    else {
#pragma unroll
        for (int i = 0; i < 32; ++i) { const int idx = lane + 64 * i, jj = idx & 127; const float v = impA[idx] + impB[idx]; impA[idx] = (jj > cur) ? 0.0f : (jj == 0 || jj == cur || jj == cur - 1) ? 1e9f : v; }
        LDS_WAIT();
        for (int qi = 0; qi < 16; ++qi) { const LAS float* iv = impA + qi * 128; const unsigned k0 = __float_as_uint(iv[lane]), k1 = __float_as_uint(iv[lane + 64]); unsigned T = 0u;
#pragma unroll 1
            for (int bit = 30; bit >= 0; --bit) { const unsigned trial = T | (1u << bit); const int cntge = __popcll(__ballot(k0 >= trial)) + __popcll(__ballot(k1 >= trial)); if (cntge >= 16) T = trial; }
            const unsigned long long lt = (1ull << lane) - 1ull, mg0 = __ballot(k0 > T), mg1 = __ballot(k1 > T), me0 = __ballot(k0 == T), me1 = __ballot(k1 == T);
            const int need = 16 - (__popcll(mg0) + __popcll(mg1));
            const bool s0 = (k0 > T) || (k0 == T && __popcll(me0 & lt) < need), s1 = (k1 > T) || (k1 == T && __popcll(me0) + __popcll(me1 & lt) < need);
            const unsigned long long m0 = __ballot(s0), m1 = __ballot(s1);
            if (s0) selL[qi * 16 + __popcll(m0 & lt)] = (unsigned char)lane;
            if (s1) selL[qi * 16 + __popcll(m0) + __popcll(m1 & lt)] = (unsigned char)(lane + 64);
            if (lane == 0) selL[256 + qi] = (unsigned char)(__popcll(m0) + __popcll(m1)); } }
    LDS_WAIT();
#pragma unroll
    for (int h = 0; h < 4; ++h)
#pragma unroll
        for (int dt = 0; dt < 4; ++dt)
#pragma unroll
            for (int j = 0; j < 4; ++j) OACC[((4 * q + j) * 4 + h) * 64 + 16 * dt + r] = GL[(4 * q + j) * 12 + 3 * h] * oc[h][dt][j];
    LDS_WAIT();
    const unsigned char* Vs8b = c.Vs8 + (size_t)(b * 2 + g) * 128 * 4096; const unsigned char* Ks8b = c.Ks8 + (size_t)(b * 2 + g) * 128 * 4096;
#define SEL_LOAD(KF, VV, JB) do { const unsigned char* Kb_ = Ks8b + (size_t)(JB) * 4096 + lane * 16; const unsigned char* Vb_ = Vs8b + (size_t)(JB) * 4096 + lane * 16; \
        _Pragma("unroll") for (int f = 0; f < 4; ++f) { KF[f] = *(const u32x4*)(Kb_ + f * 1024); VV[f] = *(const u32x4*)(Vb_ + f * 1024); } } while (0)
#define SEL_COMPUTE(KF, VV, JB) do { f32x4 s_[4]; __builtin_amdgcn_s_setprio(1);     \
        _Pragma("unroll") for (int k4 = 0; k4 < 4; ++k4) { s_[k4] = MFMA8(mk64(KF[k4].x, KF[k4].y), qs8[0], z4); s_[k4] = MFMA8(mk64(KF[k4].z, KF[k4].w), qs8[1], s_[k4]); } \
        __builtin_amdgcn_s_setprio(0); \
        f32x4 sm = rho == 0 ? s_[0] : rho == 1 ? s_[1] : rho == 2 ? s_[2] : s_[3]; \
        if ((JB) == cur) { _Pragma("unroll") for (int j = 0; j < 4; ++j) if (64 * (JB) + 16 * rho + 4 * q + j > t) sm[j] = -1e30f; } \
        float tm = fmaxf(fmaxf(sm[0], sm[1]), fmaxf(sm[2], sm[3])); \
        tm = fmaxf(tm, pg8::dppf<0x124>(tm, tm)); tm = fmaxf(tm, pg8::dppf<0x128>(tm, tm)); tm = fmaxf(tm, __shfl_xor(tm, 16)); tm = fmaxf(tm, __shfl_xor(tm, 32)); \
        if (__ballot(tm > ms) != 0ull) { const float mn = fmaxf(ms, tm), al = __expf((ms - mn) * 0.125f); ms = mn; lsum *= al; const f32x4 av = (f32x4){rdlane(al, 0), rdlane(al, 1), rdlane(al, 2), rdlane(al, 3)}; \
            _Pragma("unroll") for (int dt = 0; dt < 4; ++dt) os[dt] *= av; } \
        const float msb = ms - 8.0f * 5.5451775f;     \
        const float p0 = __expf((sm[0] - msb) * 0.125f), p1 = __expf((sm[1] - msb) * 0.125f), p2 = __expf((sm[2] - msb) * 0.125f), p3 = __expf((sm[3] - msb) * 0.125f); lsum += (p0 + p1) + (p2 + p3); \
        const unsigned pk = pk4fp8(p0, p1, p2, p3); const long a0 = mk64(pk & me0, pk & mo0), a1 = mk64(pk & me1, pk & mo1); \
        _Pragma("unroll") for (int dt = 0; dt < 4; ++dt) { const u32x4 v0 = VV[dt >> 1], v1 = VV[2 + (dt >> 1)]; \
            os[dt] = MFMA8(a0, (dt & 1) ? mk64(v0.z, v0.w) : mk64(v0.x, v0.y), os[dt]); os[dt] = MFMA8(a1, (dt & 1) ? mk64(v1.z, v1.w) : mk64(v1.x, v1.y), os[dt]); } } while (0)
    const int rho = r >> 2; const unsigned me0 = rho == 0 ? 0xffffffffu : 0u, mo0 = rho == 1 ? 0xffffffffu : 0u, me1 = rho == 2 ? 0xffffffffu : 0u, mo1 = rho == 3 ? 0xffffffffu : 0u;
    for (int qi = 0; qi < 16; ++qi) { const int t = t0 + qi, cnt = __builtin_amdgcn_readfirstlane((int)selL[256 + qi]);
        long qs8[2];
#pragma unroll
        for (int ks = 0; ks < 2; ++ks) { const u32x4 w = __builtin_bit_cast(u32x4, ld8(Pb + (size_t)t * PLD + C_Q + (4 * g + (r & 3)) * 64 + 32 * ks + 8 * q));
            qs8[ks] = mk64(pk4fp8(__uint_as_float(w.x << 16), __uint_as_float(w.x & 0xffff0000u), __uint_as_float(w.y << 16), __uint_as_float(w.y & 0xffff0000u)),
                           pk4fp8(__uint_as_float(w.z << 16), __uint_as_float(w.z & 0xffff0000u), __uint_as_float(w.w << 16), __uint_as_float(w.w & 0xffff0000u))); }
        float ms = -1e30f, lsum = 0.f; f32x4 os[4];
#pragma unroll
        for (int dt = 0; dt < 4; ++dt) os[dt] = z4;
        u32x4 kfA[4], kfB[4], vvA[4], vvB[4];
        int bi = 0, jbA = __builtin_amdgcn_readfirstlane((int)selL[qi * 16]), jbB = jbA;
        SEL_LOAD(kfA, vvA, jbA);
        for (;;) {
            if (bi + 1 < cnt) { jbB = __builtin_amdgcn_readfirstlane((int)selL[qi * 16 + bi + 1]); SEL_LOAD(kfB, vvB, jbB); }
            SEL_COMPUTE(kfA, vvA, jbA);
            if (++bi >= cnt) break;
            if (bi + 1 < cnt) { jbA = __builtin_amdgcn_readfirstlane((int)selL[qi * 16 + bi + 1]); SEL_LOAD(kfA, vvA, jbA); }
            SEL_COMPUTE(kfB, vvB, jbB);
            if (++bi >= cnt) break; }
        lsum += pg8::dppf<0x124>(lsum, lsum); lsum += pg8::dppf<0x128>(lsum, lsum); lsum += __shfl_xor(lsum, 16); lsum += __shfl_xor(lsum, 32);
#pragma unroll
        for (int dt = 0; dt < 4; ++dt)
#pragma unroll
            for (int j = 0; j < 4; ++j) { float v = os[dt][j]; v += __shfl_xor(v, 16); v += __shfl_xor(v, 32); os[dt][j] = v; }
        const float l0 = rdlane(lsum, 0), l1 = rdlane(lsum, 1), l2 = rdlane(lsum, 2), l3 = rdlane(lsum, 3);
        const float lq = q == 0 ? l0 : q == 1 ? l1 : q == 2 ? l2 : l3; const float gsc = GL[qi * 12 + 3 * q + 1] / lq;
#pragma unroll
        for (int dt = 0; dt < 4; ++dt) { const float v = q == 0 ? os[dt][0] : q == 1 ? os[dt][1] : q == 2 ? os[dt][2] : os[dt][3]; OACC[(qi * 4 + q) * 64 + 16 * dt + r] += gsc * v; } }
#undef SEL_LOAD
#undef SEL_COMPUTE
    LDS_WAIT();
    LOAD_QF();
#undef LOAD_QF
    float mw[4], lw[4]; f32x4 ow[4][4];
#pragma unroll
    for (int h = 0; h < 4; ++h) { mw[h] = -1e30f; lw[h] = 0.f;
#pragma unroll
        for (int dt = 0; dt < 4; ++dt) ow[h][dt] = z4; }
    const bf16_t* VwTb = c.VwT + (size_t)(b * 2 + g) * 128 * 4096; const bf16_t* KwCb = c.KwC + (size_t)(b * 2 + g) * S * 64; const int tq = t0 + r;
    for (int ke = (t0 - 512) & ~31; ke <= t0; ke += 32) { if (ke < 0) continue; f32x4 pp[4][2];
        const size_t boff = (size_t)(ke >> 6) * 4096 + lane * 8; const int kp2 = (ke & 63) >> 5; const bool fullw = (ke + 31 <= t0) && (ke >= t0 - 496);
        bf16x8 kf[2][2], vf[4];
#pragma unroll
        for (int hf = 0; hf < 2; ++hf) { kf[hf][0] = ld8(KwCb + boff + ((2 * kp2 + hf) * 2) * 512); kf[hf][1] = ld8(KwCb + boff + ((2 * kp2 + hf) * 2 + 1) * 512); }
#pragma unroll
        for (int dt = 0; dt < 4; ++dt) vf[dt] = ld8(VwTb + boff + (kp2 * 4 + dt) * 512);
#pragma unroll
        for (int hf = 0; hf < 2; ++hf) { const int k0t = ke + 16 * hf;
#pragma unroll
            for (int h = 0; h < 4; ++h) { f32x4 s = MFMA16(kf[hf][0], qf[h][0], z4); s = MFMA16(kf[hf][1], qf[h][1], s);
                if (!fullw) {
#pragma unroll
                    for (int j = 0; j < 4; ++j) { const int kk = k0t + 4 * q + j; if (kk > tq || kk <= tq - 512) s[j] = -1e30f; } }
                pp[h][hf] = s; } }
        bf16x8 pa[4];
#pragma unroll
        for (int h = 0; h < 4; ++h) { float tm = -1e30f;
#pragma unroll
            for (int j = 0; j < 4; ++j) tm = fmaxf(tm, fmaxf(pp[h][0][j], pp[h][1][j]));
            tm = fmaxf(tm, __shfl_xor(tm, 16)); tm = fmaxf(tm, __shfl_xor(tm, 32));
            if (__ballot(tm > mw[h]) != 0ull) {
                const float mn = fmaxf(mw[h], tm), al = __expf(mw[h] - mn); mw[h] = mn; lw[h] *= al;
                const f32x4 av = (f32x4){__shfl(al, 4 * q), __shfl(al, 4 * q + 1), __shfl(al, 4 * q + 2), __shfl(al, 4 * q + 3)};
#pragma unroll
                for (int dt = 0; dt < 4; ++dt) ow[h][dt] *= av; }
            const float mn = mw[h]; float ps = 0.f;
#pragma unroll
            for (int hf = 0; hf < 2; ++hf)
#pragma unroll
                for (int j = 0; j < 4; ++j) { const float p = pp[h][hf][j] > -1e29f ? __expf(pp[h][hf][j] - mn) : 0.f; pp[h][hf][j] = p; ps += p; }
            lw[h] += ps;
            pa[h] = pack8(pp[h][0], pp[h][1]); }
#pragma unroll
        for (int dt = 0; dt < 4; ++dt)
#pragma unroll
            for (int h = 0; h < 4; ++h) ow[h][dt] = MFMA16(pa[h], vf[dt], ow[h][dt]); }
#pragma unroll
    for (int h = 0; h < 4; ++h) { lw[h] += __shfl_xor(lw[h], 16); lw[h] += __shfl_xor(lw[h], 32);
        const f32x4 lr = (f32x4){__shfl(lw[h], 4 * q), __shfl(lw[h], 4 * q + 1), __shfl(lw[h], 4 * q + 2), __shfl(lw[h], 4 * q + 3)};
#pragma unroll
        for (int dt = 0; dt < 4; ++dt)
#pragma unroll
            for (int j = 0; j < 4; ++j) { const int qi = 4 * q + j; const float val = OACC[(qi * 4 + h) * 64 + 16 * dt + r] + GL[qi * 12 + 3 * h + 2] * ow[h][dt][j] / lr[j];
                c.CAT[(rowb + t0 + qi) * D + 1024 + (4 * g + h) * 64 + 16 * dt + r] = f2bf1(val); } }
    LDS_WAIT();
}
__device__ __forceinline__ void mem_item(const Ctx& c, int item, int lane) {
    const int qt = item & 511, h = (item >> 9) & 3, b = item >> 11, r = lane & 15, q = lane >> 4; const size_t rowb = (size_t)b * S + 16 * qt;
    const f32x4 z4 = (f32x4){0.f, 0.f, 0.f, 0.f};
    bf16x8 qm[4];
#pragma unroll
    for (int ks = 0; ks < 4; ++ks) qm[ks] = ld8(c.P + (rowb + r) * PLD + C_MQ + 128 * h + 32 * ks + 8 * q);
    f32x4 s[16]; float mx = -1e30f;
#pragma unroll
    for (int kt = 0; kt < 16; ++kt) { s[kt] = z4; const bf16_t* kp = c.MK + (size_t)(b * 4 + h) * 32768 + kt * 2048 + lane * 8;
#pragma unroll
        for (int ks = 0; ks < 4; ++ks) s[kt] = MFMA16(ld8(kp + 512 * ks), qm[ks], s[kt]);
        s[kt] *= 0.08838834764831845f;
#pragma unroll
        for (int j = 0; j < 4; ++j) mx = fmaxf(mx, s[kt][j]); }
    mx = fmaxf(mx, __shfl_xor(mx, 16)); mx = fmaxf(mx, __shfl_xor(mx, 32)); float ls = 0.f;
#pragma unroll
    for (int kt = 0; kt < 16; ++kt)
#pragma unroll
        for (int j = 0; j < 4; ++j) { s[kt][j] = __expf(s[kt][j] - mx); ls += s[kt][j]; }
    ls += __shfl_xor(ls, 16); ls += __shfl_xor(ls, 32);
    f32x4 o[8];
#pragma unroll
    for (int dt = 0; dt < 8; ++dt) o[dt] = z4;
#pragma unroll
    for (int kp = 0; kp < 8; ++kp) { const bf16x8 pa = pack8(s[2 * kp], s[2 * kp + 1]);
#pragma unroll
        for (int dt = 0; dt < 8; ++dt) o[dt] = MFMA16(pa, ld8(c.MVT + (size_t)(b * 4 + h) * 32768 + (kp * 8 + dt) * 512 + lane * 8), o[dt]); }
    const f32x4 lr = (f32x4){__shfl(ls, 4 * q), __shfl(ls, 4 * q + 1), __shfl(ls, 4 * q + 2), __shfl(ls, 4 * q + 3)};
#pragma unroll
    for (int dt = 0; dt < 8; ++dt)
#pragma unroll
        for (int j = 0; j < 4; ++j) c.CAT[(rowb + 4 * q + j) * D + 1536 + 128 * h + 16 * dt + r] = f2bf1(o[dt][j] / lr[j]);
}
__global__ void __launch_bounds__(512, 2) hymba_fwd(Args a) {
    extern __shared__ __attribute__((aligned(16))) unsigned char lds_raw[];
    LAS unsigned char* lds = (LAS unsigned char*)lds_raw;
    cg::grid_group grid = cg::this_grid();
    Ctx c;
    c.x = a.in[0]; c.mem = a.in[1]; c.ln_in_g = a.in[2]; c.ln_in_b = a.in[3]; c.w_in = a.in[4]; c.lru_cw = a.in[5]; c.lru_cb = a.in[6]; c.lru_wa = a.in[7]; c.lru_ba = a.in[8]; c.lru_wx = a.in[9]; c.lru_bx = a.in[10];
    c.lru_lam = a.in[11]; c.pe_k = a.in[12]; c.w1k = a.in[13]; c.w2k = a.in[14]; c.pe_v = a.in[15]; c.w1v = a.in[16]; c.w2v = a.in[17]; c.w_mem = a.in[18]; c.w_out = a.in[19]; c.ln1_g = a.in[20]; c.ln1_b = a.in[21];
    c.w_up = a.in[22]; c.fcw = a.in[23]; c.fcb = a.in[24]; c.w_down = a.in[25]; c.ln2_g = a.in[26]; c.ln2_b = a.in[27]; c.out = a.out;
    unsigned char* ws = a.ws;
    c.WinT = (bf16_t*)(ws + WS_WIN); c.WoutT = (bf16_t*)(ws + WS_WOUT); c.WupT = (bf16_t*)(ws + WS_WUP); c.WdownT = (bf16_t*)(ws + WS_WDOWN); c.WmemT = (bf16_t*)(ws + WS_WMEM); c.MEMB = (bf16_t*)(ws + WS_MEMB);
    c.WaT = (bf16_t*)(ws + WS_WAT); c.WxT = (bf16_t*)(ws + WS_WXT); c.W1kT = (bf16_t*)(ws + WS_W1K); c.W1vT = (bf16_t*)(ws + WS_W1V); c.W2kT = (bf16_t*)(ws + WS_W2K); c.W2vT = (bf16_t*)(ws + WS_W2V);
    c.MK = (bf16_t*)(ws + WS_MK); c.MVT = (bf16_t*)(ws + WS_MVT); c.KCMP = (bf16_t*)(ws + WS_KCMP); c.VCMPT = (bf16_t*)(ws + WS_VCMPT); c.AGG = (float2*)(ws + WS_AGG); c.VsT = (bf16_t*)(ws + WS_VST); c.VwT = (bf16_t*)(ws + WS_VWT); c.KsC = (bf16_t*)(ws + WS_KSC); c.KwC = (bf16_t*)(ws + WS_KWC);
    c.STAT0 = (float2*)(ws + WS_STAT0); c.STAT1 = (float2*)(ws + WS_STAT1); c.Ks8 = ws + WS_KS8; c.Vs8 = ws + WS_VS8; c.LA = (float*)(ws + WS_LA); c.LU = (float*)(ws + WS_LU); c.MIX = (bf16_t*)(ws + WS_MIX); c.FFN = (bf16_t*)(ws + WS_FFN); c.H0B = (bf16_t*)(ws + WS_H0B); c.P = (bf16_t*)(ws + WS_P); c.CAT = (bf16_t*)(ws + WS_CAT); c.H1B = (bf16_t*)(ws + WS_H1B); c.ACT = (bf16_t*)(ws + WS_ACT);
    const int tid = threadIdx.x, lane = tid & 63, wave = __builtin_amdgcn_readfirstlane(tid >> 6), G = gridDim.x, gw = blockIdx.x * 8 + wave, NGW = G * 8;
    const int lo = a.ph_lo, hi = a.ph_hi;
#define IN(k) (lo <= (k) && (k) < hi)
    volatile LAS unsigned* bst = (volatile LAS unsigned*)(lds + 147392);
    if (tid < 2) bst[tid] = 0u;
    __syncthreads();
    if (blockIdx.x == 0) for (int i = tid; i < 4096; i += 512) ((unsigned*)ws)[i] = 0u;
    XcdBarrier xbar; xbar.bar = (unsigned*)ws; xbar.x = 0; xbar.st = bst;
#define SEAM(k) do { if (IN(k) && IN((k) + 1)) { if ((k) == 0) { grid.sync(); xbar = xcd_barrier_post((unsigned*)ws, bst); } else xcd_barrier(xbar); } } while (0)
    if (IN(0)) phase0(c, lds, gw, NGW, wave, lane);
    SEAM(0);
    if (IN(1)) { pg8::Gemm g{c.H0B, c.WinT, T, NINP, D, 0}; pg8::StaticOrder so; so.init(T, NINP, G, (int)blockIdx.x); pg8::EpiBf16<0> E{c.P, PLD, nullptr, 0, 0};
        pg8::gemm_phase<pg8::EpiBf16<0>, pg8::StaticOrder, false>(lds, g, so, E, nullptr); }
    SEAM(1);
    if (IN(2)) {
        for (int bt = blockIdx.x; bt < 256; bt += G) vt_tile(c, lds, bt, tid);
        for (int base = blockIdx.x * 8; base < 2048; base += G * 8) lru_walk1(c, lds, base, tid);
        for (int task = gw; task < 2048; task += NGW) memkv_task(c, task, lane);
        for (int task = blockIdx.x; task < 256; task += G) compress_task(c, lds, task, tid);
    }
    SEAM(2);
    if (IN(3)) {
        for (int base = blockIdx.x * 8; base < 2048; base += G * 8) lru_walk2(c, lds, base, tid);
        {
          const int xcd = blockIdx.x & 7, slot = blockIdx.x >> 3;
          const int item0 = (G == 256) ? (((xcd & 3) << 9) | (((slot * 8 + wave) << 1) | (xcd >> 2))) : gw, istep = (G == 256) ? 4096 : NGW;
          for (int item = item0; item < 2048; item += istep) nsa_item(c, lds + wave * 16384, lds + 131072 + wave * 1280, item, lane); }
        { unsigned* qctr = (unsigned*)ws + 3584;
          for (;;) { int item = 0; if (lane == 0) item = (int)atomicAdd(qctr, 1u); item = __builtin_amdgcn_readfirstlane(item); if (item >= 4096) break; mem_item(c, item, lane); } }
    }
    SEAM(3);
    if (IN(4)) { pg8::Gemm g{c.CAT, c.WoutT, T, D, D, 0}; pg8::StaticOrder so; so.init(T, D, G, (int)blockIdx.x); pg8::EpiBf16<0> E{c.MIX, D, nullptr, 0, 0};
        pg8::gemm_phase<pg8::EpiBf16<0>, pg8::StaticOrder, false>(lds, g, so, E, nullptr); }
    SEAM(4);
    if (IN(5)) { for (int m = gw; m < T; m += 2 * NGW) ln_fuse_rows<2>(c.x, c.STAT0, c.ln_in_g, c.ln_in_b, c.MIX, c.out, c.ln1_g, c.ln1_b, nullptr, c.H1B, c.STAT1, m, NGW, lane); }
    SEAM(5);
    if (IN(6)) { pg8::Gemm g{c.H1B, c.WupT, 66 * 256, 2 * DFF, D, 1}; pg8::StaticOrder so; so.init(66 * 256, 2 * DFF, G, (int)blockIdx.x); pg8::EpiConvGeglu E{c.ACT, c.fcw, c.fcb, (LAS float*)(lds + EX_OFF)};
        pg8::gemm_phase<pg8::EpiConvGeglu, pg8::StaticOrder, false>(lds, g, so, E, nullptr);
        const int first = (66 * 44) % G, nw = (G - first) * 8;
        if ((int)blockIdx.x >= first) for (int it = ((int)blockIdx.x - first) * 8 + wave; it < 88 * 32; it += nw) transpose_item<0>(c.w_down, 5632, 2048, c.WdownT, (LAS float*)(lds + wave * 16640), it, 32, lane); }
    SEAM(6);
    if (IN(7)) { pg8::Gemm g{c.ACT, c.WdownT, T, D, DFF, 0}; pg8::StaticOrder so; so.init(T, D, G, (int)blockIdx.x, 16); pg8::EpiBf16<0> E{c.FFN, D, nullptr, 0, 0};
        pg8::gemm_phase<pg8::EpiBf16<0>, pg8::StaticOrder, false>(lds, g, so, E, nullptr); }
    SEAM(7);
    if (IN(8)) { for (int m = gw; m < T; m += 2 * NGW) ln_fuse_rows<2>(c.out, c.STAT1, c.ln1_g, c.ln1_b, c.FFN, nullptr, c.ln2_g, c.ln2_b, c.out, nullptr, nullptr, m, NGW, lane); }
#undef IN
#undef SEAM
}

extern "C" void kernel_launch(void* const* d_in, const int* in_sizes, int n_in, void* d_out, int out_size, void* d_ws, size_t ws_size, hipStream_t stream) {
    static int grid = 0;
    if (grid == 0) {
        if (n_in != 28 || out_size != T * D || ws_size < WS_END) { fprintf(stderr, "kernel_launch: unexpected shapes (n_in %d, out %d, ws %zu)\n", n_in, out_size, ws_size); grid = -1; return; }
        int dev = 0, cus = 0, per_cu = 0;
        (void)hipGetDevice(&dev); (void)hipDeviceGetAttribute(&cus, hipDeviceAttributeMultiprocessorCount, dev);
        if (hipFuncSetAttribute((const void*)hymba_fwd, hipFuncAttributeMaxDynamicSharedMemorySize, LDS_BYTES) != hipSuccess) { fprintf(stderr, "kernel_launch: hipFuncSetAttribute failed\n"); grid = -1; return; }
        if (hipOccupancyMaxActiveBlocksPerMultiprocessor(&per_cu, (const void*)hymba_fwd, 512, LDS_BYTES) != hipSuccess || per_cu < 1) per_cu = 1;
        (void)hipGetLastError();
        grid = cus * per_cu;
        fprintf(stderr, "kernel_launch: grid %d (cus %d x %d)\n", grid, cus, per_cu);
    }
    if (grid < 0) return;
    Args a{};
    for (int i = 0; i < 28; ++i) a.in[i] = (const float*)d_in[i];
    a.out = (float*)d_out; a.ws = (unsigned char*)d_ws; a.ph_lo = 0; a.ph_hi = 9;
    void* args[] = {&a};
    const hipError_t e = hipLaunchCooperativeKernel((void*)hymba_fwd, dim3(grid), dim3(512), args, LDS_BYTES, stream);
    if (e != hipSuccess) fprintf(stderr, "kernel_launch: cooperative launch failed: %s (grid %d)\n", hipGetErrorString(e), grid);
}
```
